# Optimizing an MI355X kernel written in HIP

```python
import jax, jax.numpy as jnp
from jax import lax
import numpy as np

D_MODEL = 2048
BATCH = 8
SEQ = 2048
DEPTH = 1

N_META = 16
D_RNN = D_MODEL
N_RNN_BLOCKS = 8
RNN_BLOCK = D_RNN // N_RNN_BLOCKS
CONV_WIDTH = 4
LRU_C = 8.0
LRU_MIN_RAD = 0.9
LRU_MAX_RAD = 0.999
HEAD_DIM = 64
N_Q_HEADS = D_MODEL // HEAD_DIM
N_KV_HEADS = N_Q_HEADS // 8
GROUP = N_Q_HEADS // N_KV_HEADS
D_ATTN = N_Q_HEADS * HEAD_DIM
D_KV = N_KV_HEADS * HEAD_DIM
WINDOW = 128
BLOCK = 128
ROPE_THETA = 10000.0
NEG_INF = -1e30
N_BRANCHES = 2
LN_EPS = 1e-5
DEEPNORM_ALPHA = (2.0 * DEPTH) ** 0.25
DEEPNORM_BETA = (8.0 * DEPTH) ** -0.25
OFF_GR = D_RNN
OFF_Q = 2 * D_RNN
OFF_K = OFF_Q + D_ATTN
OFF_V = OFF_K + D_KV
OFF_GA = OFF_V + D_KV
OFF_G = OFF_GA + D_ATTN
D_IN = OFF_G + N_BRANCHES * D_MODEL

kernel_name = "hybrid_rglru_swa_sink_gated_merge"


def layer_norm(x, g, b):
    xf = x.astype(jnp.float32)
    mu = xf.mean(-1, keepdims=True)
    var = jnp.square(xf - mu).mean(-1, keepdims=True)
    y = (xf - mu) * lax.rsqrt(var + LN_EPS)
    return (y * g.astype(jnp.float32) + b.astype(jnp.float32)).astype(x.dtype)


def rope(x, pos):
    half = HEAD_DIM // 2
    inv = ROPE_THETA ** (-jnp.arange(half, dtype=jnp.float32) / half)
    ang = pos.astype(jnp.float32)[:, None] * inv[None, :]
    cos = jnp.cos(ang)[None, :, None, :]
    sin = jnp.sin(ang)[None, :, None, :]
    xf = x.astype(jnp.float32)
    x1, x2 = xf[..., :half], xf[..., half:]
    return jnp.concatenate([x1 * cos - x2 * sin, x2 * cos + x1 * sin], axis=-1).astype(x.dtype)


def causal_depthwise_conv(x, w, b):
    T = x.shape[1]
    xp = jnp.pad(x, ((0, 0), (CONV_WIDTH - 1, 0), (0, 0)))
    y = b
    for k in range(CONV_WIDTH):
        s = CONV_WIDTH - 1 - k
        y = y + w[k] * xp[:, s:s + T]
    return y


def rg_lru(x, w_ra, b_ra, w_ri, b_ri, lam):
    B, T, _ = x.shape
    xb = x.reshape(B, T, N_RNN_BLOCKS, RNN_BLOCK)
    gate_r = jax.nn.sigmoid((jnp.einsum('btnc,ncd->btnd', xb, w_ra).reshape(B, T, D_RNN) + b_ra).astype(jnp.float32))
    gate_i = jax.nn.sigmoid((jnp.einsum('btnc,ncd->btnd', xb, w_ri).reshape(B, T, D_RNN) + b_ri).astype(jnp.float32))
    log_a = LRU_C * gate_r * jax.nn.log_sigmoid(lam.astype(jnp.float32))
    a = jnp.exp(log_a)
    mult = jnp.sqrt(-jnp.expm1(2.0 * log_a))
    mult = jnp.where((jnp.arange(T) == 0)[None, :, None], 1.0, mult)
    u = mult * gate_i * x.astype(jnp.float32)

    def combine(left, right):
        a1, b1 = left
        a2, b2 = right
        return a1 * a2, a2 * b1 + b2

    _, h = lax.associative_scan(combine, (a, u), axis=1)
    return h.astype(x.dtype)


def sliding_window_sink_attention(q, k, v, sinks):
    B, T = q.shape[:2]
    pad = BLOCK - N_META
    Lp = T + pad
    NB = Lp // BLOCK
    padf = lambda t: jnp.pad(t, ((0, 0), (pad, 0), (0, 0), (0, 0)))
    qb = padf(q).reshape(B, NB, BLOCK, N_KV_HEADS, GROUP, HEAD_DIM)
    kb = padf(k).reshape(B, NB, BLOCK, N_KV_HEADS, HEAD_DIM)
    vb = padf(v).reshape(B, NB, BLOCK, N_KV_HEADS, HEAD_DIM)

    def banded(t):
        prev = jnp.pad(t, ((0, 0), (1, 0), (0, 0), (0, 0), (0, 0)))[:, :NB]
        meta = jnp.broadcast_to(t[:, :1, pad:], (B, NB, N_META, N_KV_HEADS, HEAD_DIM))
        return jnp.concatenate([meta, prev, t], axis=2)

    kk, vv = banded(kb), banded(vb)

    qi = jnp.arange(NB)[:, None] * BLOCK + jnp.arange(BLOCK)[None, :]
    jb = (jnp.arange(NB)[:, None] - 1) * BLOCK + jnp.arange(2 * BLOCK)[None, :]
    jm = pad + jnp.arange(N_META)
    band_ok = ((jb[:, None, :] >= BLOCK) & (jb[:, None, :] <= qi[:, :, None])
               & (qi[:, :, None] - jb[:, None, :] < WINDOW))
    meta_ok = jnp.broadcast_to(jm[None, None, :] <= qi[:, :, None], (NB, BLOCK, N_META))
    mask = jnp.concatenate([meta_ok, band_ok], axis=-1)

    s = jnp.einsum('bnqkgd,bnskd->bnkgqs', qb, kk).astype(jnp.float32) * (HEAD_DIM ** -0.5)
    s = jnp.where(mask[None, :, None, None], s, NEG_INF)
    sink = sinks.astype(jnp.float32).reshape(N_KV_HEADS, GROUP)[None, None, :, :, None, None]
    m = jnp.maximum(s.max(-1, keepdims=True), sink)
    p = jnp.exp(s - m)
    denom = p.sum(-1, keepdims=True) + jnp.exp(sink - m)
    o = jnp.einsum('bnkgqs,bnskd->bnqkgd', (p / denom).astype(v.dtype), vv)
    return o.reshape(B, Lp, D_ATTN)[:, pad:]


def hybrid_layer(h, pos, w_in, b_in, conv_w, conv_b, w_ra, b_ra, w_ri, b_ri, lam, sinks,
                 w_rnn_out, w_attn_out, w_o, b_o, ln_g, ln_b):
    B, T, _ = h.shape
    z = h @ w_in + b_in
    xr, gr, q, k, v, ga, mg = jnp.split(z, [OFF_GR, OFF_Q, OFF_K, OFF_V, OFF_GA, OFF_G], axis=-1)

    hr = rg_lru(causal_depthwise_conv(xr, conv_w, conv_b), w_ra, b_ra, w_ri, b_ri, lam)
    y_a = (hr * jax.nn.silu(gr)) @ w_rnn_out

    q = rope(q.reshape(B, T, N_Q_HEADS, HEAD_DIM), pos)
    k = rope(k.reshape(B, T, N_KV_HEADS, HEAD_DIM), pos)
    v = v.reshape(B, T, N_KV_HEADS, HEAD_DIM)
    o = sliding_window_sink_attention(q, k, v, sinks)
    y_b = (o * jax.nn.silu(ga)) @ w_attn_out

    g = jax.nn.sigmoid(mg.astype(jnp.float32)).astype(h.dtype)
    mixed = g[..., :D_MODEL] * y_a + g[..., D_MODEL:] * y_b
    out = mixed @ w_o + b_o
    return layer_norm(DEEPNORM_ALPHA * h + out, ln_g, ln_b)


def setup_inputs(seed: int = 0) -> dict:
    key = jax.random.key(seed)
    ks = jax.random.split(key, 24)
    f32 = jnp.float32
    nrm = lambda k, shape, scale: jax.random.normal(k, shape, f32) * scale
    u = jax.random.uniform(ks[12], (DEPTH, D_RNN), f32, LRU_MIN_RAD, LRU_MAX_RAD)
    s_rad = u ** (1.0 / LRU_C)
    lru_lambda = jnp.log(s_rad) - jnp.log1p(-s_rad)
    return {
        "x": jax.random.normal(ks[0], (BATCH, SEQ, D_MODEL), f32),
        "meta_tokens": nrm(ks[1], (N_META, D_MODEL), 1.0),
        "ln_emb_g": 1.0 + nrm(ks[2], (D_MODEL,), 0.01),
        "ln_emb_b": nrm(ks[3], (D_MODEL,), 0.01),
        "w_in": nrm(ks[4], (DEPTH, D_MODEL, D_IN), D_MODEL ** -0.5),
        "b_in": nrm(ks[5], (DEPTH, D_IN), 0.01),
        "conv_w": nrm(ks[6], (DEPTH, CONV_WIDTH, D_RNN), CONV_WIDTH ** -0.5),
        "conv_b": nrm(ks[7], (DEPTH, D_RNN), 0.01),
        "w_ra": nrm(ks[8], (DEPTH, N_RNN_BLOCKS, RNN_BLOCK, RNN_BLOCK), RNN_BLOCK ** -0.5),
        "b_ra": nrm(ks[9], (DEPTH, D_RNN), 0.01),
        "w_ri": nrm(ks[10], (DEPTH, N_RNN_BLOCKS, RNN_BLOCK, RNN_BLOCK), RNN_BLOCK ** -0.5),
        "b_ri": nrm(ks[11], (DEPTH, D_RNN), 0.01),
        "lru_lambda": lru_lambda,
        "sinks": nrm(ks[13], (DEPTH, N_Q_HEADS), 0.5),
        "w_rnn_out": nrm(ks[14], (DEPTH, D_RNN, D_MODEL), D_RNN ** -0.5 * DEEPNORM_BETA),
        "w_attn_out": nrm(ks[15], (DEPTH, D_ATTN, D_MODEL), D_ATTN ** -0.5 * DEEPNORM_BETA),
        "w_o": nrm(ks[16], (DEPTH, D_MODEL, D_MODEL), D_MODEL ** -0.5 * DEEPNORM_BETA),
        "b_o": nrm(ks[17], (DEPTH, D_MODEL), 0.01),
        "ln_g": 1.0 + nrm(ks[18], (DEPTH, D_MODEL), 0.01),
        "ln_b": nrm(ks[19], (DEPTH, D_MODEL), 0.01),
    }


def reference(x, meta_tokens, ln_emb_g, ln_emb_b, w_in, b_in, conv_w, conv_b, w_ra, b_ra, w_ri, b_ri,
              lru_lambda, sinks, w_rnn_out, w_attn_out, w_o, b_o, ln_g, ln_b):
    B = x.shape[0]
    meta = jnp.broadcast_to(meta_tokens.astype(x.dtype)[None], (B, N_META, D_MODEL))
    h = jnp.concatenate([meta, x], axis=1)
    h = layer_norm(h, ln_emb_g, ln_emb_b)
    pos = jnp.arange(h.shape[1])
    for l in range(DEPTH):
        h = hybrid_layer(h, pos, w_in[l], b_in[l], conv_w[l], conv_b[l], w_ra[l], b_ra[l], w_ri[l], b_ri[l],
                         lru_lambda[l], sinks[l], w_rnn_out[l], w_attn_out[l], w_o[l], b_o[l], ln_g[l], ln_b[l])
    return h[:, N_META:]
```

```cpp
#include <hip/hip_runtime.h>
#include <cstdio>
#include <cstdint>

#ifndef MK_SPLIT
#define MK_SPLIT 0
#endif

namespace pg8 {
#define PG8_LAS __attribute__((address_space(3)))
typedef unsigned short bf16_t;
typedef short bf16x8 __attribute__((ext_vector_type(8)));
typedef float f32x4 __attribute__((ext_vector_type(4)));
typedef unsigned u32x4 __attribute__((ext_vector_type(4)));
constexpr int BM = 256, BK = 64, HALF = 128, HTB = HALF * BK * 2, STAGE_BYTES = 8 * HTB, NXCD = 8, WGM = 8;

__host__ __device__ __forceinline__ int lds_byte(int r, int c) { const int st = (r >> 4) * 2 + (c >> 5), rr = r & 15, cc = c & 31, ob = rr * 64 + cc * 2; return st * 1024 + (ob ^ (((ob >> 9) & 1) << 5)); }
__host__ __device__ __forceinline__ void stage_rc(int b, int& R, int& C) { const int st = b / 1024, sb = b % 1024, swz = sb ^ (((sb >> 9) & 1) << 5); R = (st >> 1) * 16 + swz / 64; C = (st & 1) * 32 + (swz % 64) / 2; }
__host__ __device__ __forceinline__ int perm32(int rho) { const int n = rho >> 4, i = rho & 15; return 8 * (i >> 2) + 4 * n + (i & 3); }

struct Unit { int pm, pn; };
struct Gemm { const bf16_t* A; const bf16_t* Bt; int M, N, K; };

struct StaticOrder {
    int nM, nN, nwg, G, c;
    __host__ __device__ void init(int M, int N, int G_, int c_) { nM = M / BM; nN = N / BM; nwg = nM * nN; G = G_; c = c_; }
    __host__ __device__ bool next(int i, Unit& u) const {
        const long L = (long)i * G + c; if (L >= nwg) return false;
        int wgid = (int)L; { const int q = nwg / NXCD, r = nwg % NXCD, xcd = wgid % NXCD, off = wgid / NXCD; wgid = (xcd < r ? xcd * (q + 1) : r * (q + 1) + (xcd - r) * q) + off; }
        const int nig = WGM * nN, gid = wgid / nig, fm = gid * WGM, gsz = (nM - fm) < WGM ? (nM - fm) : WGM;
        u.pm = fm + ((wgid % nig) % gsz); u.pn = (wgid % nig) / gsz; return true;
    }
    __device__ __forceinline__ void a_ready(const Unit&) const {}
    __device__ __forceinline__ void done(const Unit&) const {}
};

__device__ __forceinline__ unsigned cvt_pk_bf16(float lo, float hi) { unsigned r; asm volatile("v_cvt_pk_bf16_f32 %0, %1, %2" : "=v"(r) : "v"(lo), "v"(hi)); return r; }

template <class Epi, class Sched, bool ALIGN_EPI = false, bool SP2 = false>
__device__ __forceinline__ void gemm_phase(PG8_LAS unsigned char* lds, const Gemm g, const Sched& S, const Epi& E) {
    const int tid = threadIdx.x, wid = __builtin_amdgcn_readfirstlane(tid >> 6), lane = tid & 63, wr = wid >> 2, wc = wid & 3, fr = lane & 15, fq = lane >> 4;
    const int K = g.K, nt = K / BK;
    unsigned voffA[2], voffB[2];
#pragma unroll
    for (int i = 0; i < 2; ++i) { int R, C; stage_rc(tid * 16 + i * 8192, R, C); const int Rb = Epi::PERM ? ((R & ~31) + perm32(R & 31)) : R;
        voffA[i] = (unsigned)(R * K + C) * 2u; voffB[i] = (unsigned)(Rb * K + C) * 2u; }
    const size_t kstep = (size_t)(BK * 2);
    const size_t hstep = (size_t)HALF * K * 2;
    const size_t tstep = 2 * hstep;
    const unsigned ldsw = (unsigned)wid * 1024u;
    const int aoff = lds_byte(wr * 64 + fr, fq * 8), boff = lds_byte(wc * 32 + fr, fq * 8);
#define PG8_SA(b, h) (((b) * 2 + (h)) * HTB)
#define PG8_SB(b, h) ((4 + (b) * 2 + (h)) * HTB)
#define PG8_STAGE(bufoff, gbase, voff) do { _Pragma("unroll") for (int _i = 0; _i < 2; ++_i) \
        __builtin_amdgcn_global_load_lds((const unsigned*)((const char*)(gbase) + (voff)[_i]), (PG8_LAS unsigned*)(lds + (bufoff) + ldsw + _i * 8192), 16, 0, 0); } while (0)
#define PG8_LDA(dst, b, h) do { _Pragma("unroll") for (int m = 0; m < 4; ++m) _Pragma("unroll") for (int k = 0; k < 2; ++k) dst[m][k] = *(const PG8_LAS bf16x8*)(lds + PG8_SA(b, h) + aoff + m * 2048 + k * 1024); } while (0)
#define PG8_LDB(dst, b, h) do { _Pragma("unroll") for (int n = 0; n < 2; ++n) _Pragma("unroll") for (int k = 0; k < 2; ++k) dst[n][k] = *(const PG8_LAS bf16x8*)(lds + PG8_SB(b, h) + boff + n * 2048 + k * 1024); } while (0)
#define PG8_MMA(ai, bj, At, Bt) do { __builtin_amdgcn_s_setprio(1); _Pragma("unroll") for (int m = 0; m < 4; ++m) _Pragma("unroll") for (int n = 0; n < 2; ++n) _Pragma("unroll") for (int k = 0; k < 2; ++k) \
        acc[ai][bj][m][n] = __builtin_amdgcn_mfma_f32_16x16x32_bf16(Bt[n][k], At[m][k], acc[ai][bj][m][n], 0, 0, 0); __builtin_amdgcn_s_setprio(0); } while (0)
#define PG8_WAIT_V(n) asm volatile("s_waitcnt vmcnt(" #n ")" ::: "memory")
#define PG8_WAIT_L(n) asm volatile("s_waitcnt lgkmcnt(" #n ")" ::: "memory")
#define PG8_BAR __builtin_amdgcn_s_barrier()
#define PG8_SCHED __builtin_amdgcn_sched_barrier(0)
    Unit cur, nxt; int ui = 0;
    if (!S.next(0, cur)) return;
    f32x4 acc[2][2][4][2];
#pragma unroll
    for (int a = 0; a < 2; ++a)
#pragma unroll
        for (int b = 0; b < 2; ++b)
#pragma unroll
            for (int m = 0; m < 4; ++m)
#pragma unroll
                for (int n = 0; n < 2; ++n) acc[a][b][m][n] = (f32x4){0.f, 0.f, 0.f, 0.f};
    bf16x8 At[4][2], B0[2][2], B1[2][2];
    const char* cA = (const char*)g.A + (size_t)cur.pm * tstep; const char* cB = (const char*)g.Bt + (size_t)cur.pn * tstep;
    S.a_ready(cur);
    if constexpr (SP2) {
        PG8_STAGE(PG8_SB(0, 0), cB, voffB); PG8_STAGE(PG8_SB(0, 1), cB + hstep, voffB); PG8_STAGE(PG8_SA(0, 0), cA, voffA); PG8_STAGE(PG8_SA(0, 1), cA + hstep, voffA);
        if (wr == 1) PG8_BAR;
        PG8_WAIT_V(2); PG8_BAR;
        PG8_STAGE(PG8_SB(1, 0), cB + kstep, voffB); PG8_STAGE(PG8_SA(1, 0), cA + kstep, voffA); PG8_STAGE(PG8_SB(1, 1), cB + hstep + kstep, voffB);
        PG8_WAIT_V(6); PG8_BAR;
    } else {
        PG8_STAGE(PG8_SB(0, 0), cB, voffB); PG8_STAGE(PG8_SA(0, 0), cA, voffA); PG8_STAGE(PG8_SB(0, 1), cB + hstep, voffB); PG8_STAGE(PG8_SA(0, 1), cA + hstep, voffA);
        if (wr == 1) PG8_BAR;
        PG8_WAIT_V(4); PG8_BAR;
        PG8_STAGE(PG8_SB(1, 0), cB + kstep, voffB); PG8_STAGE(PG8_SA(1, 0), cA + kstep, voffA); PG8_STAGE(PG8_SB(1, 1), cB + hstep + kstep, voffB);
        PG8_WAIT_V(6); PG8_BAR;
    }
    for (;;) {
        const bool has_next = S.next(ui + 1, nxt);
        const char* nA = has_next ? (const char*)g.A + (size_t)nxt.pm * tstep : cA; const char* nB = has_next ? (const char*)g.Bt + (size_t)nxt.pn * tstep : cB;
        for (int t = 0; t < nt; t += 2) {
            const bool last = (t == nt - 2);
            const char* a1 = cA + (size_t)(t + 1) * kstep;
            const char* a2 = last ? nA : cA + (size_t)(t + 2) * kstep; const char* b2 = last ? nB : cB + (size_t)(t + 2) * kstep;
            const char* a3 = a2 + kstep; const char* b3 = b2 + kstep;
            if (last && has_next) S.a_ready(nxt);
            if constexpr (Epi::HAS_MID) { if (t == (nt >> 1)) E.mid(acc, cur, wr, wc, fr, fq); }
            if constexpr (SP2) {
            PG8_LDB(B0, 0, 0); PG8_LDB(B1, 0, 1); PG8_SCHED; PG8_LDA(At, 0, 0); PG8_STAGE(PG8_SA(1, 1), a1 + hstep, voffA);
            PG8_WAIT_V(8); PG8_WAIT_L(0); PG8_BAR; PG8_MMA(0, 0, At, B0); PG8_MMA(0, 1, At, B1); PG8_BAR; PG8_SCHED;
            PG8_LDA(At, 0, 1); PG8_STAGE(PG8_SB(0, 0), b2, voffB); PG8_STAGE(PG8_SB(0, 1), b2 + hstep, voffB); PG8_STAGE(PG8_SA(0, 0), a2, voffA);
            PG8_WAIT_V(8); PG8_WAIT_L(0); PG8_BAR; PG8_MMA(1, 0, At, B0); PG8_MMA(1, 1, At, B1); PG8_BAR; PG8_SCHED;
            PG8_LDB(B0, 1, 0); PG8_LDB(B1, 1, 1); PG8_SCHED; PG8_LDA(At, 1, 0); PG8_STAGE(PG8_SA(0, 1), a2 + hstep, voffA);
            PG8_WAIT_V(8); PG8_WAIT_L(0); PG8_BAR; PG8_MMA(0, 0, At, B0); PG8_MMA(0, 1, At, B1); PG8_BAR; PG8_SCHED;
            PG8_LDA(At, 1, 1); PG8_STAGE(PG8_SB(1, 0), b3, voffB); PG8_STAGE(PG8_SB(1, 1), b3 + hstep, voffB); PG8_STAGE(PG8_SA(1, 0), a3, voffA);
            PG8_WAIT_V(8); PG8_WAIT_L(0); PG8_BAR; PG8_MMA(1, 0, At, B0); PG8_MMA(1, 1, At, B1); PG8_BAR; PG8_SCHED;
            } else {
            PG8_LDB(B0, 0, 0); PG8_SCHED; PG8_LDA(At, 0, 0); PG8_STAGE(PG8_SA(1, 1), a1 + hstep, voffA);
            PG8_WAIT_L(8); PG8_BAR; PG8_WAIT_L(0); PG8_MMA(0, 0, At, B0); PG8_BAR; PG8_SCHED;
            PG8_LDB(B1, 0, 1); PG8_STAGE(PG8_SB(0, 0), b2, voffB);
            PG8_BAR; PG8_WAIT_L(0); PG8_MMA(0, 1, At, B1); PG8_BAR;
            PG8_LDA(At, 0, 1); PG8_STAGE(PG8_SA(0, 0), a2, voffA);
            PG8_BAR; PG8_WAIT_L(0); PG8_MMA(1, 0, At, B0); PG8_BAR; PG8_SCHED;
            PG8_STAGE(PG8_SB(0, 1), b2 + hstep, voffB);
            PG8_WAIT_V(6); PG8_BAR; PG8_MMA(1, 1, At, B1); PG8_BAR;
            PG8_LDB(B0, 1, 0); PG8_SCHED; PG8_LDA(At, 1, 0); PG8_STAGE(PG8_SA(0, 1), a2 + hstep, voffA);
            PG8_WAIT_L(8); PG8_BAR; PG8_WAIT_L(0); PG8_MMA(0, 0, At, B0); PG8_BAR; PG8_SCHED;
            PG8_LDB(B1, 1, 1); PG8_STAGE(PG8_SB(1, 0), b3, voffB);
            PG8_BAR; PG8_WAIT_L(0); PG8_MMA(0, 1, At, B1); PG8_BAR;
            PG8_LDA(At, 1, 1); PG8_STAGE(PG8_SA(1, 0), a3, voffA);
            PG8_BAR; PG8_WAIT_L(0); PG8_MMA(1, 0, At, B0); PG8_BAR; PG8_SCHED;
            PG8_STAGE(PG8_SB(1, 1), b3 + hstep, voffB);
            PG8_WAIT_V(6); PG8_BAR; PG8_MMA(1, 1, At, B1); PG8_BAR;
            }
        }
        if constexpr (ALIGN_EPI) { if (wr == 0) PG8_BAR; }
        E(acc, cur, wr, wc, fr, fq); S.done(cur);
        if (!has_next) break;
#pragma unroll
        for (int a = 0; a < 2; ++a)
#pragma unroll
            for (int b = 0; b < 2; ++b)
#pragma unroll
                for (int m = 0; m < 4; ++m)
#pragma unroll
                    for (int n = 0; n < 2; ++n) acc[a][b][m][n] = (f32x4){0.f, 0.f, 0.f, 0.f};
        cur = nxt; cA = nA; cB = nB; ++ui;
        if constexpr (ALIGN_EPI) { if (wr == 1) PG8_BAR; }
    }
    PG8_WAIT_V(0);
    if constexpr (!ALIGN_EPI) { if (wr == 0) PG8_BAR; }
    PG8_BAR;
#undef PG8_SA
#undef PG8_SB
#undef PG8_STAGE
#undef PG8_LDA
#undef PG8_LDB
#undef PG8_MMA
#undef PG8_WAIT_V
#undef PG8_WAIT_L
#undef PG8_BAR
#undef PG8_SCHED
}
}

constexpr int NWAVES = 8;
constexpr int DM = 2048, BATCH = 8, SEQ = 2048, NMETA = 16, TT = SEQ + NMETA, M = BATCH * SEQ, DIN = 12800;
constexpr int OFF_GR = 2048, OFF_Q = 4096, OFF_K = 6144, OFF_V = 6400, OFF_GA = 6656, OFF_G = 8704;
constexpr int DKV = 256, NKV = 4, GROUP = 8, HD = 64;
constexpr float LN_EPS = 1e-5f;
constexpr float DN_ALPHA = 1.189207115002721f;
constexpr float LOG2E = 1.4426950408889634f;
constexpr float QSCALE = 0.125f * LOG2E;

constexpr size_t MiB = 1u << 20;
constexpr size_t WS_CTL = 0, CTL_ZERO_BYTES = 1 * MiB;
constexpr size_t WS_STATS = 1 * MiB;
constexpr size_t WS_ROPE = 1 * MiB + 256 * 1024;
constexpr size_t WS_KVMETA = 1 * MiB + 832 * 1024;
constexpr size_t WS_LNP = 2 * MiB;
constexpr size_t WS_WG = 6 * MiB;
constexpr size_t WS_WIN = 8 * MiB;
constexpr size_t WS_WY = 58 * MiB;
constexpr size_t WS_WO = 74 * MiB;
constexpr size_t WS_XR = 82 * MiB;
constexpr size_t WS_K = 148 * MiB, WS_V = 156 * MiB;
constexpr size_t WS_AC = 164 * MiB;
constexpr size_t WS_MG = 292 * MiB;
constexpr size_t WS_MIX = 420 * MiB;
constexpr size_t WS_END = 484 * MiB;
constexpr size_t OUT_H = 0, OUT_Q = 64 * MiB;

constexpr int CW_TMO = 0, CW_CODE = 1, CW_BAR = 4096;

constexpr int RING_BYTES = 131072, LDSCTL_OFF = RING_BYTES, MISC_OFF = LDSCTL_OFF + 320, LDS_BYTES = 147456;

#define GAS __attribute__((address_space(1)))
#define LAS __attribute__((address_space(3)))
typedef unsigned short bf16;
typedef unsigned v4u __attribute__((ext_vector_type(4)));
typedef unsigned v2u __attribute__((ext_vector_type(2)));
typedef float f32x4 __attribute__((ext_vector_type(4)));
typedef float f32x2 __attribute__((ext_vector_type(2)));
typedef float f32x16 __attribute__((ext_vector_type(16)));
typedef short bf16x8 __attribute__((ext_vector_type(8)));
typedef short s16x4 __attribute__((ext_vector_type(4)));
typedef GAS unsigned gu32;
#define RLX_AGENT __ATOMIC_RELAXED, __HIP_MEMORY_SCOPE_AGENT
#define LDS_WAIT() asm volatile("s_waitcnt lgkmcnt(0)" ::: "memory")
#define VM_WAIT() asm volatile("s_waitcnt vmcnt(0)" ::: "memory")
__device__ __forceinline__ unsigned f2bf(float f) { unsigned u = __builtin_bit_cast(unsigned, f); return (u + 0x7fffu + ((u >> 16) & 1u)) >> 16; }
__device__ __forceinline__ unsigned pk2(float lo, float hi) { return f2bf(lo) | (f2bf(hi) << 16); }
__device__ __forceinline__ float bf_lo(unsigned w) { return __builtin_bit_cast(float, w << 16); }
__device__ __forceinline__ float bf_hi(unsigned w) { return __builtin_bit_cast(float, w & 0xffff0000u); }
__device__ __forceinline__ float sigmoidf_fast(float x) { return __builtin_amdgcn_rcpf(1.f + __expf(-x)); }

#define XB_TMO      128
#define XB_XCNT(j)  (256  + 64 * (j))
#define XB_XSUB(j)  (1280 + 64 * (j))
#define XB_XGEN(j)  (2304 + 64 * (j))
#define XB_TOP      3328
#define XB_TOPGEN   3392
#define XCD_BAR_WORDS 3456
#define XB_SPIN_CAP (1u << 18)
__device__ __forceinline__ unsigned xb_ld(unsigned* p)              { return __hip_atomic_load(p, __ATOMIC_RELAXED, __HIP_MEMORY_SCOPE_AGENT); }
__device__ __forceinline__ unsigned xb_add(unsigned* p, unsigned v) { return __hip_atomic_fetch_add(p, v, __ATOMIC_RELAXED, __HIP_MEMORY_SCOPE_AGENT); }
__device__ __forceinline__ unsigned xb_xcc_id() { return (unsigned)__builtin_amdgcn_s_getreg((3 << 11) | 20) & 0xFu; }
#define XB_SPIN(cond, bar) do { unsigned _sp = 0; while (cond) { __builtin_amdgcn_s_sleep(1); \
    if ((++_sp & 255u) == 0u) { if (xb_ld(&(bar)[XB_TMO])) break; if (_sp > XB_SPIN_CAP) { atomicAdd(&(bar)[XB_TMO], 1u); break; } } } } while (0)
struct XcdBarrier { unsigned* bar; unsigned x; volatile LAS unsigned* st; };
__device__ __forceinline__ XcdBarrier xcd_barrier_post(unsigned* bar, volatile LAS unsigned* st) {
    XcdBarrier b; b.bar = bar; b.x = xb_xcc_id(); b.st = st;
    if (threadIdx.x == 0) (void)xb_add(&bar[XB_XCNT(b.x)], 1u);
    return b;
}
__device__ __forceinline__ void xcd_barrier_complete(unsigned* bar, unsigned x, unsigned& nloc, unsigned& nx) {
    const unsigned G = gridDim.x * gridDim.y * gridDim.z;
    unsigned sum, cnt, mine, sp = 0u;
    for (;;) {
        sum = 0u; cnt = 0u; mine = 0u;
#pragma unroll
        for (unsigned j = 0; j < 16; ++j) { const unsigned c = xb_ld(&bar[XB_XCNT(j)]); sum += c; cnt += (c > 0u) ? 1u : 0u; mine = (j == x) ? c : mine; }
        if (sum == G) break;
        __builtin_amdgcn_s_sleep(1);
        if ((++sp & 255u) == 0u) { if (xb_ld(&bar[XB_TMO])) break; if (sp > XB_SPIN_CAP) { atomicAdd(&bar[XB_TMO], 1u); break; } }
    }
    nloc = mine > 0u ? mine : 1u; nx = cnt > 0u ? cnt : 1u;
}
__device__ __forceinline__ void xcd_barrier(const XcdBarrier& b) {
    asm volatile("s_waitcnt vmcnt(0)" ::: "memory");
    __syncthreads();
    if (threadIdx.x == 0) {
        unsigned* bar = b.bar;
        __builtin_amdgcn_s_waitcnt(0);
        unsigned nloc = b.st[0], nx = b.st[1];
        if (nloc == 0u) { xcd_barrier_complete(bar, b.x, nloc, nx); b.st[0] = nloc; b.st[1] = nx; }
        const unsigned old = xb_add(&bar[XB_XSUB(b.x)], 1u);
        const unsigned gen = old / nloc;
        if (old + 1u == (gen + 1u) * nloc) {
            __builtin_amdgcn_fence(__ATOMIC_RELEASE, "agent");
            asm volatile("s_waitcnt vmcnt(0)" ::: "memory");
            const unsigned og = xb_add(&bar[XB_TOP], 1u);
            const unsigned tg = og / nx;
            if (og + 1u == (tg + 1u) * nx) xb_add(&bar[XB_TOPGEN], 1u);
            else XB_SPIN(xb_ld(&bar[XB_TOPGEN]) == tg, bar);
            __builtin_amdgcn_fence(__ATOMIC_ACQUIRE, "agent");
            xb_add(&bar[XB_XGEN(b.x)], 1u);
            asm volatile("s_waitcnt vmcnt(0)" ::: "memory");
        } else {
            XB_SPIN(xb_ld(&bar[XB_XGEN(b.x)]) == gen, bar);
            __builtin_amdgcn_fence(__ATOMIC_ACQUIRE, "agent");
            asm volatile("s_waitcnt vmcnt(0)" ::: "memory");
        }
    }
    __syncthreads();
}

struct Frame {
    LAS unsigned char* lds;
    volatile LAS unsigned* MISC;
    gu32* ctl;
    int tid, lane, wave, vcu, G;
    const float *x, *meta, *lne_g, *lne_b, *w_in, *b_in, *conv_w, *conv_b, *w_ra, *b_ra, *w_ri, *b_ri, *lam, *sinks, *w_rnn, *w_attn, *w_o, *b_o, *ln_g, *ln_b;
    float* out;
    unsigned char* ws;
};
__device__ __forceinline__ float wave_sum(float v) {
#pragma unroll
    for (int o = 1; o < 64; o <<= 1) v += __shfl_xor(v, o);
    return v;
}

template <class RowFn>
__device__ __forceinline__ void p0_transpose_item(const float* W, int ldw, bf16* WT, int ldk, int koff, LAS float* scr, int k0, int n0, int lane, RowFn rowfn) {
#pragma unroll 8
    for (int i = 0; i < 32; ++i) { const int kk = 2 * i + (lane >> 5); scr[kk * 33 + (lane & 31)] = W[(size_t)(k0 + kk) * ldw + n0 + (lane & 31)]; }
    LDS_WAIT(); asm volatile("" ::: "memory");
    const int c = lane & 7;
#pragma unroll
    for (int j = 0; j < 4; ++j) { const int n = (lane >> 3) + 8 * j; const LAS float* s = scr + (8 * c) * 33 + n;
        v4u o; o.x = pk2(s[0 * 33], s[1 * 33]); o.y = pk2(s[2 * 33], s[3 * 33]); o.z = pk2(s[4 * 33], s[5 * 33]); o.w = pk2(s[6 * 33], s[7 * 33]);
        *(GAS v4u*)(WT + (size_t)rowfn(n0 + n) * ldk + koff + k0 + 8 * c) = o; }
    LDS_WAIT(); asm volatile("" ::: "memory");
}
__device__ __forceinline__ int win_row(int c) { const int pn = c >> 8, L = c & 255; return (pn << 8) + (((L >> 5) & 1) << 7) + ((L >> 6) << 5) + (L & 31); }
__device__ __forceinline__ int wg_row(int d, int g) { const int q = d >> 6, cq = d & 63, w = cq >> 3, e = cq & 7; return q * 128 + w * 16 + (e >> 1) * 4 + g * 2 + (e & 1); }

__device__ __forceinline__ void ln_row_to_bf16(const float* xrow, const float* g, const float* be, bf16* orow, float* stat, int lane) {
    const GAS f32x4* xr = (const GAS f32x4*)xrow + lane;
    f32x4 v[8]; float s = 0.f;
#pragma unroll
    for (int j = 0; j < 8; ++j) { v[j] = xr[64 * j]; s += (v[j].x + v[j].y) + (v[j].z + v[j].w); }
    const float mean = wave_sum(s) * (1.f / DM); float s2 = 0.f;
#pragma unroll
    for (int j = 0; j < 8; ++j) { v[j] = v[j] - mean; s2 += (v[j].x * v[j].x + v[j].y * v[j].y) + (v[j].z * v[j].z + v[j].w * v[j].w); }
    const float rstd = 1.f / sqrtf(wave_sum(s2) * (1.f / DM) + LN_EPS);
    if (stat && lane == 0) { stat[0] = mean; stat[1] = rstd; }
    GAS unsigned long long* o8 = (GAS unsigned long long*)orow + lane;
#pragma unroll
    for (int j = 0; j < 8; ++j) { const f32x4 gg = *((const GAS f32x4*)g + lane + 64 * j), bb = *((const GAS f32x4*)be + lane + 64 * j);
        const f32x4 y = v[j] * rstd * gg + bb;
        o8[64 * j] = (unsigned long long)pk2(y.x, y.y) | ((unsigned long long)pk2(y.z, y.w) << 32); }
}

__device__ __forceinline__ void p0_meta(Frame& F, int grp) {
    LAS float* hm = (LAS float*)F.lds;
    for (int r = F.wave * 2; r < F.wave * 2 + 2; ++r) {
        const GAS f32x4* xr = (const GAS f32x4*)(F.meta + (size_t)r * DM) + F.lane;
        f32x4 v[8]; float s = 0.f;
#pragma unroll
        for (int j = 0; j < 8; ++j) { v[j] = xr[64 * j]; s += (v[j].x + v[j].y) + (v[j].z + v[j].w); }
        const float mean = wave_sum(s) * (1.f / DM); float s2 = 0.f;
#pragma unroll
        for (int j = 0; j < 8; ++j) { v[j] = v[j] - mean; s2 += (v[j].x * v[j].x + v[j].y * v[j].y) + (v[j].z * v[j].z + v[j].w * v[j].w); }
        const float rstd = 1.f / sqrtf(wave_sum(s2) * (1.f / DM) + LN_EPS);
#pragma unroll
        for (int j = 0; j < 8; ++j) { const f32x4 gg = *((const GAS f32x4*)F.lne_g + F.lane + 64 * j), bb = *((const GAS f32x4*)F.lne_b + F.lane + 64 * j);
            f32x4 y = v[j] * rstd * gg + bb;
            y.x = bf_lo(f2bf(y.x)); y.y = bf_lo(f2bf(y.y)); y.z = bf_lo(f2bf(y.z)); y.w = bf_lo(f2bf(y.w));
            *((LAS f32x4*)(hm + r * DM) + F.lane + 64 * j) = y; }
    }
    LDS_WAIT(); __syncthreads();
    const int colbase = grp < 32 ? 64 * grp : (grp < 36 ? OFF_K + 64 * (grp - 32) : OFF_V + 64 * (grp - 36));
    const int col = colbase + F.lane, ks = F.wave;
    float acc[16];
#pragma unroll
    for (int r = 0; r < 16; ++r) acc[r] = 0.f;
    const float* wp = F.w_in + (size_t)(ks * 256) * DIN + col;
    for (int k = 0; k < 256; k += 4) {
        float w0 = wp[(size_t)(k + 0) * DIN], w1 = wp[(size_t)(k + 1) * DIN], w2 = wp[(size_t)(k + 2) * DIN], w3 = wp[(size_t)(k + 3) * DIN];
        w0 = bf_lo(f2bf(w0)); w1 = bf_lo(f2bf(w1)); w2 = bf_lo(f2bf(w2)); w3 = bf_lo(f2bf(w3));
#pragma unroll
        for (int r = 0; r < 16; ++r) { const f32x4 h4 = *(const LAS f32x4*)(hm + r * DM + ks * 256 + k); acc[r] += h4.x * w0 + h4.y * w1 + h4.z * w2 + h4.w * w3; }
    }
    __syncthreads();
    LAS float* red = (LAS float*)F.lds;
#pragma unroll
    for (int r = 0; r < 16; ++r) red[(ks * 16 + r) * 64 + F.lane] = acc[r];
    LDS_WAIT(); __syncthreads();
    LAS float* zz = red + 8 * 16 * 64;
    for (int pass = 0; pass < 2; ++pass) { const int o = F.tid + 512 * pass, r = o >> 6, c = o & 63; float s = F.b_in[colbase + c];
#pragma unroll
        for (int k8 = 0; k8 < 8; ++k8) s += red[(k8 * 16 + r) * 64 + c];
        zz[r * 64 + c] = s; }
    LDS_WAIT(); __syncthreads();
    const float* cosT = (const float*)(F.ws + WS_ROPE); const float* sinT = cosT + TT * 32;
    for (int pass = 0; pass < 2; ++pass) { const int o = F.tid + 512 * pass, r = o >> 6, c = o & 63; const float v = zz[r * 64 + c];
        if (grp < 32) { const unsigned short b16 = (unsigned short)f2bf(v);
            for (int b = 0; b < BATCH; ++b) ((bf16*)(F.ws + WS_XR))[(size_t)(b * TT + r) * DM + colbase + c] = b16; }
        else if (grp < 36) { const int d = c & 31; const float x1 = zz[r * 64 + d], x2 = zz[r * 64 + 32 + d];
            const float inv = (float)pow(10000.0, -(double)d / 32.0); const float ang = (float)r * inv; const float cs = (float)cos((double)ang), sn = (float)sin((double)ang);
            const float y = (c < 32) ? (x1 * cs - x2 * sn) : (x2 * cs + x1 * sn);
            ((bf16*)(F.ws + WS_KVMETA))[r * DKV + (grp - 32) * 64 + c] = (unsigned short)f2bf(y); (void)cosT; (void)sinT; }
        else ((bf16*)(F.ws + WS_KVMETA))[16 * DKV + r * DKV + (grp - 36) * 64 + c] = (unsigned short)f2bf(v);
    }
    __syncthreads();
}

__device__ __forceinline__ void p0_prologue(Frame& F) {
    LAS float* scr = (LAS float*)(F.lds + F.wave * 16384);
    const int gw = F.vcu * NWAVES + F.wave, NGW = F.G * NWAVES;
    constexpr int I_IN = (DM / 64) * (DIN / 32), I_SQ = (DM / 64) * (DM / 32), I_G = 8 * (256 / 64) * (256 / 32);
    constexpr int NITEMS = I_IN + 3 * I_SQ + 2 * I_G;
    for (int it = gw; it < NITEMS; it += NGW) {
        int r = it;
        if (r < I_IN) { const int nblk = DIN / 32, kb = r / nblk, nb = r % nblk;
            p0_transpose_item(F.w_in, DIN, (bf16*)(F.ws + WS_WIN), DM, 0, scr, 64 * kb, 32 * nb, F.lane, [](int n) { return win_row(n); }); continue; } r -= I_IN;
        if (r < I_SQ) { const int kb = r / 64, nb = r % 64; p0_transpose_item(F.w_rnn, DM, (bf16*)(F.ws + WS_WY), 2 * DM, 0, scr, 64 * kb, 32 * nb, F.lane, [](int n) { return n; }); continue; } r -= I_SQ;
        if (r < I_SQ) { const int kb = r / 64, nb = r % 64; p0_transpose_item(F.w_attn, DM, (bf16*)(F.ws + WS_WY), 2 * DM, DM, scr, 64 * kb, 32 * nb, F.lane, [](int n) { return n; }); continue; } r -= I_SQ;
        if (r < I_SQ) { const int kb = r / 64, nb = r % 64; p0_transpose_item(F.w_o, DM, (bf16*)(F.ws + WS_WO), DM, 0, scr, 64 * kb, 32 * nb, F.lane, [](int n) { return n; }); continue; } r -= I_SQ;
        { const int g = r / I_G, rr = r % I_G, blk = rr / 32, kb = (rr % 32) / 8, nb = rr % 8; const float* W = (g ? F.w_ri : F.w_ra) + (size_t)blk * 65536;
          p0_transpose_item(W, 256, (bf16*)(F.ws + WS_WG) + (size_t)blk * 512 * 256, 256, 0, scr, 64 * kb, 32 * nb, F.lane, [g](int n) { return wg_row(n, g); }); }
    }
    bf16* H = (bf16*)((unsigned char*)F.out + OUT_H); float* stats = (float*)(F.ws + WS_STATS);
    for (int m = gw; m < M; m += NGW) ln_row_to_bf16(F.x + (size_t)m * DM, F.lne_g, F.lne_b, H + (size_t)m * DM, stats + 2 * m, F.lane);
    { float* cosT = (float*)(F.ws + WS_ROPE); float* sinT = cosT + TT * 32;
      for (int i = (F.vcu * NWAVES + F.wave) * 64 + F.lane; i < TT * 32; i += NGW * 64) { const int p = i >> 5, d = i & 31;
          const float inv = (float)pow(10000.0, -(double)d / 32.0); const float ang = (float)p * inv; cosT[i] = (float)cos((double)ang); sinT[i] = (float)sin((double)ang); } }
    __syncthreads();
    if (F.vcu >= F.G - 40) p0_meta(F, F.vcu - (F.G - 40));
}

struct EpiZ {
    static constexpr bool PERM = true, HAS_MID = false;
    const float* bias; const float* cosT; const float* sinT; bf16 *XR, *AC, *Q, *Kb, *Vb, *MG;
    __device__ __forceinline__ void operator()(const f32x4 (&acc)[2][2][4][2], const pg8::Unit& u, int wr, int wc, int fr, int fq) const {
        const int pn = u.pn; const int row0 = u.pm * 256 + wr * 64 + fr;
        const int lc0 = pn * 256 + wc * 64 + 8 * fq;
        f32x4 bv[2][2];
#pragma unroll
        for (int bj = 0; bj < 2; ++bj)
#pragma unroll
            for (int n = 0; n < 2; ++n) bv[bj][n] = *(const f32x4*)(bias + lc0 + 32 * bj + 4 * n);
        if (pn >= 16 && pn < 25) {
            const bool isq = pn < 24; bf16* dst = isq ? Q : Kb; const int pitch = isq ? DM : DKV; const int cb = (isq ? (pn - 16) * 256 : 0) + wc * 64 + 8 * fq; const float sc = isq ? QSCALE : 1.f;
#pragma unroll
            for (int ai = 0; ai < 2; ++ai)
#pragma unroll
                for (int m = 0; m < 4; ++m) { const int row = row0 + ai * 128 + m * 16; const int pos = NMETA + (row & (SEQ - 1));
                    const f32x4 c0 = *(const f32x4*)(cosT + pos * 32 + 8 * fq), c1 = *(const f32x4*)(cosT + pos * 32 + 8 * fq + 4), s0 = *(const f32x4*)(sinT + pos * 32 + 8 * fq), s1 = *(const f32x4*)(sinT + pos * 32 + 8 * fq + 4);
                    const f32x4 a0 = acc[ai][0][m][0] + bv[0][0], a1 = acc[ai][0][m][1] + bv[0][1], b0 = acc[ai][1][m][0] + bv[1][0], b1 = acc[ai][1][m][1] + bv[1][1];
                    const f32x4 y0 = (a0 * c0 - b0 * s0) * sc, y1 = (a1 * c1 - b1 * s1) * sc, z0 = (b0 * c0 + a0 * s0) * sc, z1 = (b1 * c1 + a1 * s1) * sc;
                    v4u w; w.x = pk2(y0[0], y0[1]); w.y = pk2(y0[2], y0[3]); w.z = pk2(y1[0], y1[1]); w.w = pk2(y1[2], y1[3]);
                    *(GAS v4u*)(dst + (size_t)row * pitch + cb) = w;
                    w.x = pk2(z0[0], z0[1]); w.y = pk2(z0[2], z0[3]); w.z = pk2(z1[0], z1[1]); w.w = pk2(z1[2], z1[3]);
                    *(GAS v4u*)(dst + (size_t)row * pitch + cb + 32) = w; }
            return;
        }
        int act, pitch, cb; bf16* dst; int rowadd = 0;
        if (pn < 8) { act = 0; dst = XR; pitch = DM; cb = lc0; rowadd = 1; }
        else if (pn < 16) { act = 1; dst = AC; pitch = 2 * DM; cb = lc0 - OFF_GR; }
        else if (pn == 25) { act = 0; dst = Vb; pitch = DKV; cb = lc0 - OFF_V; }
        else if (pn < 34) { act = 1; dst = AC; pitch = 2 * DM; cb = DM + lc0 - OFF_GA; }
        else { act = 2; dst = MG; pitch = 2 * DM; cb = lc0 - OFF_G; }
#pragma unroll
        for (int ai = 0; ai < 2; ++ai)
#pragma unroll
            for (int m = 0; m < 4; ++m) { const int row = row0 + ai * 128 + m * 16; const size_t orow = rowadd ? (size_t)(row + NMETA * ((row >> 11) + 1)) : (size_t)row;
#pragma unroll
                for (int bj = 0; bj < 2; ++bj) { f32x4 v0 = acc[ai][bj][m][0] + bv[bj][0], v1 = acc[ai][bj][m][1] + bv[bj][1];
                    if (act == 1) {
#pragma unroll
                        for (int j = 0; j < 4; ++j) { v0[j] = v0[j] * sigmoidf_fast(v0[j]); v1[j] = v1[j] * sigmoidf_fast(v1[j]); } }
                    else if (act == 2) {
#pragma unroll
                        for (int j = 0; j < 4; ++j) { v0[j] = sigmoidf_fast(v0[j]); v1[j] = sigmoidf_fast(v1[j]); } }
                    v4u w; w.x = pk2(v0[0], v0[1]); w.y = pk2(v0[2], v0[3]); w.z = pk2(v1[0], v1[1]); w.w = pk2(v1[2], v1[3]);
                    *(GAS v4u*)(dst + orow * pitch + cb + 32 * bj) = w; } }
    }
};

constexpr int XC_PITCH = 528;
template <int CTRL> __device__ __forceinline__ float dpp_f(float oldv, float src) {
    return __builtin_bit_cast(float, __builtin_amdgcn_update_dpp(__builtin_bit_cast(int, oldv), __builtin_bit_cast(int, src), CTRL, 0xF, 0xF, false)); }
#define SCAN_STEP(S_) do { const float Ap0 = dpp_f<0x110 + S_>(1.f, A0), Bp0 = dpp_f<0x110 + S_>(0.f, B0), Ap1 = dpp_f<0x110 + S_>(1.f, A1), Bp1 = dpp_f<0x110 + S_>(0.f, B1); \
    B0 = A0 * Bp0 + B0; A0 = A0 * Ap0; B1 = A1 * Bp1 + B1; A1 = A1 * Ap1; } while (0)

__device__ __forceinline__ void p2_scan_item(Frame& F, int item) {
    const int b = item >> 5, nb = (item >> 2) & 7, q = item & 3;
    const int tid = F.tid, lane = F.lane, w = F.wave, fr = lane & 15, fq = lane >> 4;
    const bf16* XR = (const bf16*)(F.ws + WS_XR) + (size_t)b * TT * DM + nb * 256;
    bf16* AC = (bf16*)(F.ws + WS_AC);
    LAS unsigned char* xcl = F.lds;
    bf16x8 wf[8];
    { const bf16* wg = (const bf16*)(F.ws + WS_WG) + ((size_t)nb * 512 + q * 128 + w * 16 + fr) * 256 + 8 * fq;
#pragma unroll
      for (int ks = 0; ks < 8; ++ks) wf[ks] = *(const GAS bf16x8*)(wg + 32 * ks); }
    const int cg = tid & 31, oct = tid >> 5;
    float cw[4][8], cbv[8];
    { const int gch = nb * 256 + 8 * cg;
#pragma unroll
      for (int k = 0; k < 4; ++k) { const f32x4 a = *(const GAS f32x4*)(F.conv_w + k * DM + gch), bq = *(const GAS f32x4*)(F.conv_w + k * DM + gch + 4);
          cw[k][0] = a.x; cw[k][1] = a.y; cw[k][2] = a.z; cw[k][3] = a.w; cw[k][4] = bq.x; cw[k][5] = bq.y; cw[k][6] = bq.z; cw[k][7] = bq.w; }
      const f32x4 a = *(const GAS f32x4*)(F.conv_b + gch), bq = *(const GAS f32x4*)(F.conv_b + gch + 4);
      cbv[0] = a.x; cbv[1] = a.y; cbv[2] = a.z; cbv[3] = a.w; cbv[4] = bq.x; cbv[5] = bq.y; cbv[6] = bq.z; cbv[7] = bq.w; }
    const int chl = 64 * q + 8 * w + 2 * fq, gch0 = nb * 256 + chl;
    const float bra0 = F.b_ra[gch0], bra1 = F.b_ra[gch0 + 1], bri0 = F.b_ri[gch0], bri1 = F.b_ri[gch0 + 1];
    const float c80 = -8.f * log1pf(expf(-F.lam[gch0])), c81 = -8.f * log1pf(expf(-F.lam[gch0 + 1]));
    float hin0 = 0.f, hin1 = 0.f;
    v4u xrow[11];
#define LOAD_ROWS(c_) do { _Pragma("unroll") for (int i = 0; i < 11; ++i) { int p = 128 * (c_) + 8 * oct - 3 + i; const bool ok = p >= 0; p = p < 0 ? 0 : (p > TT - 1 ? TT - 1 : p); \
            v4u v = *(const GAS v4u*)(XR + (size_t)p * DM + 8 * cg); if (!ok) v = (v4u){0u, 0u, 0u, 0u}; xrow[i] = v; } } while (0)
    LOAD_ROWS(0);
    constexpr int NCH = 17;
    for (int c = 0; c < NCH; ++c) {
#pragma unroll
        for (int e = 0; e < 8; ++e) {
            float y[8];
#pragma unroll
            for (int j = 0; j < 8; ++j) y[j] = cbv[j];
#pragma unroll
            for (int k = 0; k < 4; ++k) { const v4u r = xrow[e + 3 - k];
                y[0] += cw[k][0] * bf_lo(r.x); y[1] += cw[k][1] * bf_hi(r.x); y[2] += cw[k][2] * bf_lo(r.y); y[3] += cw[k][3] * bf_hi(r.y);
                y[4] += cw[k][4] * bf_lo(r.z); y[5] += cw[k][5] * bf_hi(r.z); y[6] += cw[k][6] * bf_lo(r.w); y[7] += cw[k][7] * bf_hi(r.w); }
            v4u o; o.x = pk2(y[0], y[1]); o.y = pk2(y[2], y[3]); o.z = pk2(y[4], y[5]); o.w = pk2(y[6], y[7]);
            *(LAS v4u*)(xcl + (8 * oct + e) * XC_PITCH + 16 * cg) = o;
        }
        if (c + 1 < NCH) LOAD_ROWS(c + 1);
        LDS_WAIT(); __syncthreads();
        const int nmt = (c == NCH - 1) ? 1 : 8;
        for (int mt = 0; mt < nmt; ++mt) {
            const int p = 128 * c + 16 * mt + fr;
            pg8::f32x4 acc = (pg8::f32x4){0.f, 0.f, 0.f, 0.f};
#pragma unroll
            for (int ks = 0; ks < 8; ++ks) { const bf16x8 xf = *(const LAS bf16x8*)(xcl + (16 * mt + fr) * XC_PITCH + 64 * ks + 16 * fq);
                acc = __builtin_amdgcn_mfma_f32_16x16x32_bf16(wf[ks], xf, acc, 0, 0, 0); }
            const unsigned xcw = *(const LAS unsigned*)(xcl + (16 * mt + fr) * XC_PITCH + 2 * chl);
            const float xc0 = bf_lo(xcw), xc1 = bf_hi(xcw);
            unsigned grw = 0u; const size_t orow = (size_t)(b * SEQ + p - NMETA);
            if (p >= NMETA) grw = *(const GAS unsigned*)(AC + orow * (2 * DM) + gch0);
            const float gr0 = sigmoidf_fast(acc[0] + bra0), gr1 = sigmoidf_fast(acc[1] + bra1), gi0 = sigmoidf_fast(acc[2] + bri0), gi1 = sigmoidf_fast(acc[3] + bri1);
            const float la0 = gr0 * c80, la1 = gr1 * c81;
            float A0 = __expf(la0), A1 = __expf(la1);
            const float x20 = 2.f * la0, x21 = 2.f * la1;
            const float em0 = x20 > -0.05f ? -x20 * (1.f + x20 * (0.5f + x20 * (0.16666667f + x20 * 0.041666668f))) : 1.f - __expf(x20);
            const float em1 = x21 > -0.05f ? -x21 * (1.f + x21 * (0.5f + x21 * (0.16666667f + x21 * 0.041666668f))) : 1.f - __expf(x21);
            float mu0 = sqrtf(em0), mu1 = sqrtf(em1); if (p == 0) { mu0 = 1.f; mu1 = 1.f; }
            float B0 = mu0 * gi0 * xc0, B1 = mu1 * gi1 * xc1;
            SCAN_STEP(1); SCAN_STEP(2); SCAN_STEP(4); SCAN_STEP(8);
            const float h0 = A0 * hin0 + B0, h1 = A1 * hin1 + B1;
            hin0 = __shfl(h0, (lane & 48) | 15); hin1 = __shfl(h1, (lane & 48) | 15);
            if (p >= NMETA) *(GAS unsigned*)(AC + orow * (2 * DM) + gch0) = pk2(h0 * bf_lo(grw), h1 * bf_hi(grw));
        }
        __syncthreads();
    }
}

constexpr int NKEY = 288;
constexpr int KCH = NKEY * 16 + 16;
constexpr int ATT_K = 0, ATT_V = 8 * KCH, ATT_VH = NKEY * 64, ATT_WS = ATT_V + 2 * ATT_VH, ATT_BYTES = ATT_WS + NWAVES * 256;
static_assert(ATT_BYTES <= RING_BYTES && (ATT_V % 16) == 0, "attention LDS map");
__device__ __forceinline__ int crow(int r, int hi) { return (r & 3) + 8 * (r >> 2) + 4 * hi; }
__device__ __forceinline__ s16x4 vtr(const LAS unsigned char* p) { typedef short v4i16_t __attribute__((ext_vector_type(4))); return __builtin_bit_cast(s16x4, __builtin_amdgcn_ds_read_tr16_b64_v4i16((LAS v4i16_t*)p)); }

__device__ __forceinline__ void p2_attn_item(Frame& F, int item) {
    const int b = item >> 6, kvh = (item >> 4) & 3, jb = item & 15;
    const int tid = F.tid, lane = F.lane, w = F.wave, r32 = lane & 31, hi = lane >> 5;
    const bf16* Kg = (const bf16*)(F.ws + WS_K); const bf16* Vg = (const bf16*)(F.ws + WS_V); const bf16* KVm = (const bf16*)(F.ws + WS_KVMETA);
    const bf16* Qg = (const bf16*)((unsigned char*)F.out + OUT_Q); bf16* AC = (bf16*)(F.ws + WS_AC);
    LAS unsigned char* L = F.lds;
    for (int piece = tid; piece < NKEY * 8; piece += 512) {
        const int key = piece >> 3, c = piece & 7; v4u kv = (v4u){0u, 0u, 0u, 0u}, vv = (v4u){0u, 0u, 0u, 0u};
        if (key < 16) { kv = *(const GAS v4u*)(KVm + key * DKV + kvh * 64 + 8 * c); vv = *(const GAS v4u*)(KVm + 16 * DKV + key * DKV + kvh * 64 + 8 * c); }
        else if (key >= 32) { const int t = 128 * (jb - 1) + (key - 32);
            if (t >= 0) { const size_t row = (size_t)(b * SEQ + t); kv = *(const GAS v4u*)(Kg + row * DKV + kvh * 64 + 8 * c); vv = *(const GAS v4u*)(Vg + row * DKV + kvh * 64 + 8 * c); } }
        *(LAS v4u*)(L + ATT_K + c * KCH + key * 16) = kv;
        *(LAS v4u*)(L + ATT_V + (c >> 2) * ATT_VH + (key >> 4) * 1024 + (key & 15) * 64 + (c & 3) * 16) = vv;
    }
    LDS_WAIT(); __syncthreads();
    const int hq = kvh * GROUP + w;
    const float sink2 = F.sinks[hq] * LOG2E;
    LAS float* wsf = (LAS float*)(L + ATT_WS) + w * 64;
    const LAS unsigned char* kbase = L + ATT_K + hi * KCH + r32 * 16;
    const LAS unsigned char* vbase = L + ATT_V + ((lane >> 4) & 1) * 32 + (lane & 3) * 8 + (4 * hi + ((lane & 15) >> 2)) * 64;
    for (int qs = 0; qs < 4; ++qs) {
        const int tok0 = 128 * jb + 32 * qs;
        const bf16* qp = Qg + (size_t)(b * SEQ + tok0 + r32) * DM + hq * 64 + hi * 8;
        bf16x8 qr[4];
#pragma unroll
        for (int d0 = 0; d0 < 4; ++d0) qr[d0] = *(const GAS bf16x8*)(qp + 16 * d0);
        f32x16 s[6];
#pragma unroll
        for (int ti = 0; ti < 6; ++ti) {
            const int krow = ti == 0 ? 0 : 32 + 32 * (qs + ti - 1);
            f32x16 a = (f32x16){0.f, 0.f, 0.f, 0.f, 0.f, 0.f, 0.f, 0.f, 0.f, 0.f, 0.f, 0.f, 0.f, 0.f, 0.f, 0.f};
#pragma unroll
            for (int d0 = 0; d0 < 4; ++d0) { const bf16x8 kf = *(const LAS bf16x8*)(kbase + (2 * d0) * KCH + krow * 16); a = __builtin_amdgcn_mfma_f32_32x32x16_bf16(kf, qr[d0], a, 0, 0, 0); }
            s[ti] = a;
        }
        const float NEG = -1e30f;
        const bool first = (jb == 0);
#pragma unroll
        for (int r = 0; r < 16; ++r) { const int kk = crow(r, hi);
            if (kk >= 16) s[0][r] = NEG;
            if (!(kk > r32) || first) s[1][r] = NEG;
            if (!(kk <= r32)) s[5][r] = NEG; }
        if (first) {
#pragma unroll
            for (int ti = 2; ti < 5; ++ti) if (qs + ti - 1 < 4) {
#pragma unroll
                for (int r = 0; r < 16; ++r) s[ti][r] = NEG; } }
        float mx = sink2;
#pragma unroll
        for (int ti = 0; ti < 6; ++ti)
#pragma unroll
            for (int r = 0; r < 16; ++r) mx = fmaxf(mx, s[ti][r]);
        { auto rr = __builtin_amdgcn_permlane32_swap(__float_as_uint(mx), __float_as_uint(mx), false, false); mx = fmaxf(__uint_as_float(rr[0]), __uint_as_float(rr[1])); }
        float lsum = 0.f;
#pragma unroll
        for (int ti = 0; ti < 6; ++ti)
#pragma unroll
            for (int r = 0; r < 16; ++r) { const float pv = __builtin_amdgcn_exp2f(s[ti][r] - mx); s[ti][r] = pv; lsum += pv; }
        { auto rr = __builtin_amdgcn_permlane32_swap(__float_as_uint(lsum), __float_as_uint(lsum), false, false); lsum = __uint_as_float(rr[0]) + __uint_as_float(rr[1]); }
        lsum += __builtin_amdgcn_exp2f(sink2 - mx);
        f32x16 o[2]; o[0] = (f32x16){0.f, 0.f, 0.f, 0.f, 0.f, 0.f, 0.f, 0.f, 0.f, 0.f, 0.f, 0.f, 0.f, 0.f, 0.f, 0.f}; o[1] = o[0];
#pragma unroll
        for (int ti = 0; ti < 6; ++ti) {
            const int krow = ti == 0 ? 0 : 32 + 32 * (qs + ti - 1);
            v4u pw0, pw1;
            pw0.x = pk2(s[ti][0], s[ti][1]); pw0.y = pk2(s[ti][2], s[ti][3]); pw0.z = pk2(s[ti][4], s[ti][5]); pw0.w = pk2(s[ti][6], s[ti][7]);
            pw1.x = pk2(s[ti][8], s[ti][9]); pw1.y = pk2(s[ti][10], s[ti][11]); pw1.z = pk2(s[ti][12], s[ti][13]); pw1.w = pk2(s[ti][14], s[ti][15]);
#pragma unroll
            for (int d0 = 0; d0 < 2; ++d0)
#pragma unroll
                for (int ks = 0; ks < 2; ++ks) { const LAS unsigned char* vp = vbase + d0 * ATT_VH + ((krow >> 4) + ks) * 1024;
                    const s16x4 lo = vtr(vp), hh = vtr(vp + 512);
                    const bf16x8 vf = (bf16x8){lo[0], lo[1], lo[2], lo[3], hh[0], hh[1], hh[2], hh[3]};
                    o[d0] = __builtin_amdgcn_mfma_f32_32x32x16_bf16(__builtin_bit_cast(bf16x8, ks ? pw1 : pw0), vf, o[d0], 0, 0, 0); }
        }
        if (hi == 0) wsf[r32] = lsum;
        LDS_WAIT();
#pragma unroll
        for (int r = 0; r < 16; ++r) { const int qi = crow(r, hi); const float rl = __builtin_amdgcn_rcpf(wsf[qi]);
            bf16* dst = AC + (size_t)(b * SEQ + tok0 + qi) * (2 * DM) + DM + hq * 64 + r32;
#pragma unroll
            for (int d0 = 0; d0 < 2; ++d0) { const float ga = bf_lo((unsigned)dst[32 * d0]); dst[32 * d0] = (unsigned short)f2bf(o[d0][r] * rl * ga); } }
        LDS_WAIT();
    }
    __syncthreads();
}

struct EpiMix {
    static constexpr bool PERM = true, HAS_MID = true;
    const bf16* MG; bf16* MIX;
    __device__ __forceinline__ void mid(pg8::f32x4 (&acc)[2][2][4][2], const pg8::Unit& u, int wr, int wc, int fr, int fq) const {
        int row0 = u.pm * 256 + wr * 64 + fr, col0 = u.pn * 256 + wc * 32 + 8 * fq;
        asm volatile("" : "+v"(row0), "+v"(col0));
#pragma unroll
        for (int ai = 0; ai < 2; ++ai)
#pragma unroll
            for (int m = 0; m < 4; ++m) { const bf16* gp = MG + (size_t)(row0 + ai * 128 + m * 16) * (2 * DM) + col0;
#pragma unroll
                for (int bj = 0; bj < 2; ++bj) { const v4u ga = *(const GAS v4u*)(gp + 128 * bj), gb = *(const GAS v4u*)(gp + DM + 128 * bj);
                    pg8::f32x4 r0, r1;
                    r0[0] = bf_lo(ga.x) * __builtin_amdgcn_rcpf(bf_lo(gb.x)); r0[1] = bf_hi(ga.x) * __builtin_amdgcn_rcpf(bf_hi(gb.x)); r0[2] = bf_lo(ga.y) * __builtin_amdgcn_rcpf(bf_lo(gb.y)); r0[3] = bf_hi(ga.y) * __builtin_amdgcn_rcpf(bf_hi(gb.y));
                    r1[0] = bf_lo(ga.z) * __builtin_amdgcn_rcpf(bf_lo(gb.z)); r1[1] = bf_hi(ga.z) * __builtin_amdgcn_rcpf(bf_hi(gb.z)); r1[2] = bf_lo(ga.w) * __builtin_amdgcn_rcpf(bf_lo(gb.w)); r1[3] = bf_hi(ga.w) * __builtin_amdgcn_rcpf(bf_hi(gb.w));
                    acc[ai][bj][m][0] *= r0; acc[ai][bj][m][1] *= r1; }
                asm volatile("" : "+v"(acc[ai][0][m][0]), "+v"(acc[ai][0][m][1]), "+v"(acc[ai][1][m][0]), "+v"(acc[ai][1][m][1]));
                asm volatile("" ::: "memory"); }
    }
    __device__ __forceinline__ void operator()(const pg8::f32x4 (&acc)[2][2][4][2], const pg8::Unit& u, int wr, int wc, int fr, int fq) const {
        const int row0 = u.pm * 256 + wr * 64 + fr, col0 = u.pn * 256 + wc * 32 + 8 * fq;
#pragma unroll
        for (int ai = 0; ai < 2; ++ai)
#pragma unroll
            for (int m = 0; m < 4; ++m) { const size_t row = (size_t)(row0 + ai * 128 + m * 16); const bf16* gp = MG + row * (2 * DM) + DM + col0;
#pragma unroll
                for (int bj = 0; bj < 2; ++bj) { const v4u gb = *(const GAS v4u*)(gp + 128 * bj); const pg8::f32x4 v0 = acc[ai][bj][m][0], v1 = acc[ai][bj][m][1];
                    v4u wv; wv.x = pk2(v0[0] * bf_lo(gb.x), v0[1] * bf_hi(gb.x)); wv.y = pk2(v0[2] * bf_lo(gb.y), v0[3] * bf_hi(gb.y)); wv.z = pk2(v1[0] * bf_lo(gb.z), v1[1] * bf_hi(gb.z)); wv.w = pk2(v1[2] * bf_lo(gb.w), v1[3] * bf_hi(gb.w));
                    *(GAS v4u*)(MIX + row * DM + col0 + 128 * bj) = wv; } }
    }
};
struct EpiOut {
    static constexpr bool PERM = false, HAS_MID = false;
    const float *x, *stats, *lne_g, *lne_b, *b_o; float* out; float* lnp;
    __device__ __forceinline__ void operator()(const pg8::f32x4 (&acc)[2][2][4][2], const pg8::Unit& u, int wr, int wc, int fr, int fq) const {
        const int row0 = u.pm * 256 + wr * 64 + fr;
        float ps[2][4], pq[2][4]; f32x2 st[2][4];
#pragma unroll
        for (int ai = 0; ai < 2; ++ai)
#pragma unroll
            for (int m = 0; m < 4; ++m) { ps[ai][m] = 0.f; pq[ai][m] = 0.f; st[ai][m] = *(const GAS f32x2*)(stats + 2 * (row0 + ai * 128 + m * 16)); }
#pragma unroll
        for (int bj = 0; bj < 2; ++bj)
#pragma unroll
            for (int n = 0; n < 2; ++n) { const int col = u.pn * 256 + bj * 128 + wc * 32 + n * 16 + 4 * fq;
                const f32x4 bo = *(const GAS f32x4*)(b_o + col), gg = *(const GAS f32x4*)(lne_g + col), be = *(const GAS f32x4*)(lne_b + col);
#pragma unroll
                for (int ai = 0; ai < 2; ++ai)
#pragma unroll
                    for (int m = 0; m < 4; ++m) { const size_t off = (size_t)(row0 + ai * 128 + m * 16) * DM + col; const f32x4 xv = *(const GAS f32x4*)(x + off);
                        const f32x4 h = (xv - st[ai][m].x) * st[ai][m].y * gg + be; const f32x4 v = acc[ai][bj][m][n] + bo + DN_ALPHA * h;
                        *(GAS f32x4*)(out + off) = v; ps[ai][m] += (v.x + v.y) + (v.z + v.w); pq[ai][m] += (v.x * v.x + v.y * v.y) + (v.z * v.z + v.w * v.w); } }
#pragma unroll
        for (int ai = 0; ai < 2; ++ai)
#pragma unroll
            for (int m = 0; m < 4; ++m) { float s = ps[ai][m], q2 = pq[ai][m]; s += __shfl_xor(s, 16); s += __shfl_xor(s, 32); q2 += __shfl_xor(q2, 16); q2 += __shfl_xor(q2, 32);
                if (fq == 0) *(GAS f32x2*)(lnp + ((size_t)(row0 + ai * 128 + m * 16) * 32 + 4 * u.pn + wc) * 2) = (f32x2){s, q2}; }
    }
};

struct Args { const float* in[20]; float* out; unsigned char* ws; int ph_lo, ph_hi; };
__global__ void __launch_bounds__(NWAVES * 64, 2) hyb_fwd(Args args) {
    extern __shared__ __attribute__((aligned(16))) unsigned char lds[];
    Frame F;
    F.lds = (LAS unsigned char*)lds; F.MISC = (volatile LAS unsigned*)(F.lds + MISC_OFF);
    F.tid = threadIdx.x; F.lane = F.tid & 63; F.wave = __builtin_amdgcn_readfirstlane(F.tid >> 6);
    F.G = gridDim.x; { const int bx = blockIdx.x; F.vcu = (F.G % 8 == 0) ? (bx % 8) * (F.G / 8) + bx / 8 : bx; }
    F.ws = args.ws; F.ctl = (gu32*)(args.ws + WS_CTL); F.out = args.out;
    F.x = args.in[0]; F.meta = args.in[1]; F.lne_g = args.in[2]; F.lne_b = args.in[3]; F.w_in = args.in[4]; F.b_in = args.in[5]; F.conv_w = args.in[6]; F.conv_b = args.in[7];
    F.w_ra = args.in[8]; F.b_ra = args.in[9]; F.w_ri = args.in[10]; F.b_ri = args.in[11]; F.lam = args.in[12]; F.sinks = args.in[13]; F.w_rnn = args.in[14]; F.w_attn = args.in[15];
    F.w_o = args.in[16]; F.b_o = args.in[17]; F.ln_g = args.in[18]; F.ln_b = args.in[19];
    for (int u = F.tid; u < (LDS_BYTES - LDSCTL_OFF) / 4; u += NWAVES * 64) ((LAS unsigned*)(F.lds + LDSCTL_OFF))[u] = 0u;
    __syncthreads();
    XcdBarrier bar; bar.bar = (unsigned*)(F.ctl + CW_BAR); bar.x = 0; bar.st = nullptr;
    if (!MK_SPLIT) bar = xcd_barrier_post((unsigned*)(F.ctl + CW_BAR), F.MISC + 8);
    const int lo = args.ph_lo, hi = args.ph_hi;
#ifndef PH_MASK
#define PH_MASK 63
#endif
#define IN(k) (((PH_MASK >> (k)) & 1) && lo <= (k) && (k) < hi)
#define SEAM(k) do { if (IN(k) && IN((k) + 1)) xcd_barrier(bar); } while (0)

    if (IN(0)) { p0_prologue(F); }
    SEAM(0);
    if (IN(1)) {
        pg8::Gemm g{(const bf16*)((unsigned char*)F.out + OUT_H), (const bf16*)(F.ws + WS_WIN), M, DIN, DM}; pg8::StaticOrder S; S.init(M, DIN, F.G, (int)blockIdx.x);
        EpiZ E{F.b_in, (const float*)(F.ws + WS_ROPE), (const float*)(F.ws + WS_ROPE) + TT * 32, (bf16*)(F.ws + WS_XR), (bf16*)(F.ws + WS_AC), (bf16*)((unsigned char*)F.out + OUT_Q), (bf16*)(F.ws + WS_K), (bf16*)(F.ws + WS_V), (bf16*)(F.ws + WS_MG)};
        pg8::gemm_phase<EpiZ, pg8::StaticOrder, true, true>(F.lds, g, S, E);
    }
    SEAM(1);
    if (IN(2)) {
        p2_scan_item(F, F.vcu);
        p2_attn_item(F, 2 * F.vcu); p2_attn_item(F, 2 * F.vcu + 1);
    }
    SEAM(2);
    if (IN(3)) {
        pg8::Gemm g{(const bf16*)(F.ws + WS_AC), (const bf16*)(F.ws + WS_WY), M, DM, 2 * DM}; pg8::StaticOrder S; S.init(M, DM, F.G, (int)blockIdx.x);
        EpiMix E{(const bf16*)(F.ws + WS_MG), (bf16*)(F.ws + WS_MIX)};
        pg8::gemm_phase<EpiMix, pg8::StaticOrder, true, true>(F.lds, g, S, E);
    }
    SEAM(3);
    if (IN(4)) {
        pg8::Gemm g{(const bf16*)(F.ws + WS_MIX), (const bf16*)(F.ws + WS_WO), M, DM, DM}; pg8::StaticOrder S; S.init(M, DM, F.G, (int)blockIdx.x);
        EpiOut E{F.x, (const float*)(F.ws + WS_STATS), F.lne_g, F.lne_b, F.b_o, F.out, (float*)(F.ws + WS_LNP)};
        pg8::gemm_phase<EpiOut, pg8::StaticOrder, true, true>(F.lds, g, S, E);
    }
    SEAM(4);
    if (IN(5)) {
        const float* lnp = (const float*)(F.ws + WS_LNP);
        const int gw = F.vcu * NWAVES + F.wave, NGW = F.G * NWAVES;
        for (int m = gw; m < M; m += NGW) {
            float s = 0.f, q2 = 0.f; if (F.lane < 32) { const f32x2 p = *(const GAS f32x2*)(lnp + ((size_t)m * 32 + F.lane) * 2); s = p.x; q2 = p.y; }
            s = wave_sum(s); q2 = wave_sum(q2);
            const float mean = s * (1.f / DM), var = fmaxf(q2 * (1.f / DM) - mean * mean, 0.f), rstd = 1.f / sqrtf(var + LN_EPS);
            GAS f32x4* o = (GAS f32x4*)(F.out + (size_t)m * DM) + F.lane;
#pragma unroll
            for (int j = 0; j < 8; ++j) { const f32x4 v = o[64 * j], gg = *((const GAS f32x4*)F.ln_g + F.lane + 64 * j), bb = *((const GAS f32x4*)F.ln_b + F.lane + 64 * j);
                o[64 * j] = (v - mean) * rstd * gg + bb; }
        }
    }
#undef IN
#undef SEAM
}

extern "C" void kernel_launch(void* const* d_in, const int* in_sizes, int n_in, void* d_out, int out_size, void* d_ws, size_t ws_size, hipStream_t stream) {
    static int grid = 0;
    if (grid == 0) {
        if (n_in != 20 || in_sizes[0] != M * DM || out_size != M * DM || ws_size < WS_END) {
            fprintf(stderr, "kernel_launch: unexpected shapes: n_in %d in0 %d out %d ws %zu (need >= %zu)\n", n_in, n_in > 0 ? in_sizes[0] : -1, out_size, ws_size, (size_t)WS_END); grid = -1; return; }
        int dev = 0, cus = 0;
        if (hipGetDevice(&dev) != hipSuccess || hipDeviceGetAttribute(&cus, hipDeviceAttributeMultiprocessorCount, dev) != hipSuccess) { grid = -1; return; }
        if (hipFuncSetAttribute((const void*)hyb_fwd, hipFuncAttributeMaxDynamicSharedMemorySize, LDS_BYTES) != hipSuccess) { fprintf(stderr, "kernel_launch: hipFuncSetAttribute failed\n"); grid = -1; return; }
        (void)hipGetLastError();
        grid = cus;
        if (grid != 256) fprintf(stderr, "kernel_launch: %d CUs; this kernel is laid out for 256\n", grid);
    }
    if (grid < 0) return;
    if (hipMemsetAsync((char*)d_ws + WS_CTL, 0, CTL_ZERO_BYTES, stream) != hipSuccess) return;
    Args a{};
    for (int i = 0; i < 20; ++i) a.in[i] = (const float*)d_in[i];
    a.out = (float*)d_out; a.ws = (unsigned char*)d_ws;
#if MK_SPLIT
    for (int ph = 0; ph < 6; ++ph) { a.ph_lo = ph; a.ph_hi = ph + 1; hipLaunchKernelGGL(hyb_fwd, dim3(grid), dim3(NWAVES * 64), LDS_BYTES, stream, a); }
#else
    a.ph_lo = 0; a.ph_hi = 6; hipLaunchKernelGGL(hyb_fwd, dim3(grid), dim3(NWAVES * 64), LDS_BYTES, stream, a);
#endif
}
```

```cpp
#include <hip/hip_runtime.h>
#include <cstdio>
#include <cstdint>

#ifndef MK_SPLIT
#define MK_SPLIT 0
#endif

namespace pg8 {
#define PG8_LAS __attribute__((address_space(3)))
typedef unsigned short bf16_t;
typedef short bf16x8 __attribute__((ext_vector_type(8)));
typedef float f32x4 __attribute__((ext_vector_type(4)));
typedef unsigned u32x4 __attribute__((ext_vector_type(4)));
constexpr int BM = 256, BK = 64, HALF = 128, HTB = HALF * BK * 2, STAGE_BYTES = 8 * HTB, NXCD = 8, WGM = 8;

__host__ __device__ __forceinline__ int lds_byte(int r, int c) { const int st = (r >> 4) * 2 + (c >> 5), rr = r & 15, cc = c & 31, ob = rr * 64 + cc * 2; return st * 1024 + (ob ^ (((ob >> 9) & 1) << 5)); }
__host__ __device__ __forceinline__ void stage_rc(int b, int& R, int& C) { const int st = b / 1024, sb = b % 1024, swz = sb ^ (((sb >> 9) & 1) << 5); R = (st >> 1) * 16 + swz / 64; C = (st & 1) * 32 + (swz % 64) / 2; }
__host__ __device__ __forceinline__ int perm32(int rho) { const int n = rho >> 4, i = rho & 15; return 8 * (i >> 2) + 4 * n + (i & 3); }

struct Unit { int pm, pn; };
struct Gemm { const bf16_t* A; const bf16_t* Bt; int M, N, K; };

struct StaticOrder {
    int nM, nN, nwg, G, c;
    __host__ __device__ void init(int M, int N, int G_, int c_) { nM = M / BM; nN = N / BM; nwg = nM * nN; G = G_; c = c_; }
    __host__ __device__ bool next(int i, Unit& u) const {
        const long L = (long)i * G + c; if (L >= nwg) return false;
        int wgid = (int)L; { const int q = nwg / NXCD, r = nwg % NXCD, xcd = wgid % NXCD, off = wgid / NXCD; wgid = (xcd < r ? xcd * (q + 1) : r * (q + 1) + (xcd - r) * q) + off; }
        const int nig = WGM * nN, gid = wgid / nig, fm = gid * WGM, gsz = (nM - fm) < WGM ? (nM - fm) : WGM;
        u.pm = fm + ((wgid % nig) % gsz); u.pn = (wgid % nig) / gsz; return true;
    }
    __device__ __forceinline__ void a_ready(const Unit&) const {}
    __device__ __forceinline__ void done(const Unit&) const {}
};

__device__ __forceinline__ unsigned cvt_pk_bf16(float lo, float hi) { unsigned r; asm volatile("v_cvt_pk_bf16_f32 %0, %1, %2" : "=v"(r) : "v"(lo), "v"(hi)); return r; }

template <class Epi, class Sched, bool ALIGN_EPI = false, bool SP2 = false>
__device__ __forceinline__ void gemm_phase(PG8_LAS unsigned char* lds, const Gemm g, const Sched& S, const Epi& E) {
    const int tid = threadIdx.x, wid = __builtin_amdgcn_readfirstlane(tid >> 6), lane = tid & 63, wr = wid >> 2, wc = wid & 3, fr = lane & 15, fq = lane >> 4;
    const int K = g.K, nt = K / BK;
    unsigned voffA[2], voffB[2];
#pragma unroll
    for (int i = 0; i < 2; ++i) { int R, C; stage_rc(tid * 16 + i * 8192, R, C); const int Rb = Epi::PERM ? ((R & ~31) + perm32(R & 31)) : R;
        voffA[i] = (unsigned)(R * K + C) * 2u; voffB[i] = (unsigned)(Rb * K + C) * 2u; }
    const size_t kstep = (size_t)(BK * 2);
    const size_t hstep = (size_t)HALF * K * 2;
    const size_t tstep = 2 * hstep;
    const unsigned ldsw = (unsigned)wid * 1024u;
    const int aoff = lds_byte(wr * 64 + fr, fq * 8), boff = lds_byte(wc * 32 + fr, fq * 8);
#define PG8_SA(b, h) (((b) * 2 + (h)) * HTB)
#define PG8_SB(b, h) ((4 + (b) * 2 + (h)) * HTB)
#define PG8_STAGE(bufoff, gbase, voff) do { _Pragma("unroll") for (int _i = 0; _i < 2; ++_i) \
        __builtin_amdgcn_global_load_lds((const unsigned*)((const char*)(gbase) + (voff)[_i]), (PG8_LAS unsigned*)(lds + (bufoff) + ldsw + _i * 8192), 16, 0, 0); } while (0)
#define PG8_LDA(dst, b, h) do { _Pragma("unroll") for (int m = 0; m < 4; ++m) _Pragma("unroll") for (int k = 0; k < 2; ++k) dst[m][k] = *(const PG8_LAS bf16x8*)(lds + PG8_SA(b, h) + aoff + m * 2048 + k * 1024); } while (0)
#define PG8_LDB(dst, b, h) do { _Pragma("unroll") for (int n = 0; n < 2; ++n) _Pragma("unroll") for (int k = 0; k < 2; ++k) dst[n][k] = *(const PG8_LAS bf16x8*)(lds + PG8_SB(b, h) + boff + n * 2048 + k * 1024); } while (0)
#define PG8_MMA(ai, bj, At, Bt) do { __builtin_amdgcn_s_setprio(1); _Pragma("unroll") for (int m = 0; m < 4; ++m) _Pragma("unroll") for (int n = 0; n < 2; ++n) _Pragma("unroll") for (int k = 0; k < 2; ++k) \
        acc[ai][bj][m][n] = __builtin_amdgcn_mfma_f32_16x16x32_bf16(Bt[n][k], At[m][k], acc[ai][bj][m][n], 0, 0, 0); __builtin_amdgcn_s_setprio(0); } while (0)
#define PG8_WAIT_V(n) asm volatile("s_waitcnt vmcnt(" #n ")" ::: "memory")
#define PG8_WAIT_L(n) asm volatile("s_waitcnt lgkmcnt(" #n ")" ::: "memory")
#define PG8_BAR __builtin_amdgcn_s_barrier()
#define PG8_SCHED __builtin_amdgcn_sched_barrier(0)
    Unit cur, nxt; int ui = 0;
    if (!S.next(0, cur)) return;
    f32x4 acc[2][2][4][2];
#pragma unroll
    for (int a = 0; a < 2; ++a)
#pragma unroll
        for (int b = 0; b < 2; ++b)
#pragma unroll
            for (int m = 0; m < 4; ++m)
#pragma unroll
                for (int n = 0; n < 2; ++n) acc[a][b][m][n] = (f32x4){0.f, 0.f, 0.f, 0.f};
    bf16x8 At[4][2], B0[2][2], B1[2][2];
    const char* cA = (const char*)g.A + (size_t)cur.pm * tstep; const char* cB = (const char*)g.Bt + (size_t)cur.pn * tstep;
    S.a_ready(cur);
    if constexpr (SP2) {
        PG8_STAGE(PG8_SB(0, 0), cB, voffB); PG8_STAGE(PG8_SB(0, 1), cB + hstep, voffB); PG8_STAGE(PG8_SA(0, 0), cA, voffA); PG8_STAGE(PG8_SA(0, 1), cA + hstep, voffA);
        if (wr == 1) PG8_BAR;
        PG8_WAIT_V(2); PG8_BAR;
        PG8_STAGE(PG8_SB(1, 0), cB + kstep, voffB); PG8_STAGE(PG8_SA(1, 0), cA + kstep, voffA); PG8_STAGE(PG8_SB(1, 1), cB + hstep + kstep, voffB);
        PG8_WAIT_V(6); PG8_BAR;
    } else {
        PG8_STAGE(PG8_SB(0, 0), cB, voffB); PG8_STAGE(PG8_SA(0, 0), cA, voffA); PG8_STAGE(PG8_SB(0, 1), cB + hstep, voffB); PG8_STAGE(PG8_SA(0, 1), cA + hstep, voffA);
        if (wr == 1) PG8_BAR;
        PG8_WAIT_V(4); PG8_BAR;
        PG8_STAGE(PG8_SB(1, 0), cB + kstep, voffB); PG8_STAGE(PG8_SA(1, 0), cA + kstep, voffA); PG8_STAGE(PG8_SB(1, 1), cB + hstep + kstep, voffB);
        PG8_WAIT_V(6); PG8_BAR;
    }
    for (;;) {
        const bool has_next = S.next(ui + 1, nxt);
        const char* nA = has_next ? (const char*)g.A + (size_t)nxt.pm * tstep : cA; const char* nB = has_next ? (const char*)g.Bt + (size_t)nxt.pn * tstep : cB;
        for (int t = 0; t < nt; t += 2) {
            const bool last = (t == nt - 2);
            const char* a1 = cA + (size_t)(t + 1) * kstep;
            const char* a2 = last ? nA : cA + (size_t)(t + 2) * kstep; const char* b2 = last ? nB : cB + (size_t)(t + 2) * kstep;
            const char* a3 = a2 + kstep; const char* b3 = b2 + kstep;
            if (last && has_next) S.a_ready(nxt);
            if constexpr (Epi::HAS_MID) { if (t == (nt >> 1)) E.mid(acc, cur, wr, wc, fr, fq); }
            if constexpr (SP2) {
            PG8_LDB(B0, 0, 0); PG8_LDB(B1, 0, 1); PG8_SCHED; PG8_LDA(At, 0, 0); PG8_STAGE(PG8_SA(1, 1), a1 + hstep, voffA);
            PG8_WAIT_V(8); PG8_WAIT_L(0); PG8_BAR; PG8_MMA(0, 0, At, B0); PG8_MMA(0, 1, At, B1); PG8_BAR; PG8_SCHED;
            PG8_LDA(At, 0, 1); PG8_STAGE(PG8_SB(0, 0), b2, voffB); PG8_STAGE(PG8_SB(0, 1), b2 + hstep, voffB); PG8_STAGE(PG8_SA(0, 0), a2, voffA);
            PG8_WAIT_V(8); PG8_WAIT_L(0); PG8_BAR; PG8_MMA(1, 0, At, B0); PG8_MMA(1, 1, At, B1); PG8_BAR; PG8_SCHED;
            PG8_LDB(B0, 1, 0); PG8_LDB(B1, 1, 1); PG8_SCHED; PG8_LDA(At, 1, 0); PG8_STAGE(PG8_SA(0, 1), a2 + hstep, voffA);
            PG8_WAIT_V(8); PG8_WAIT_L(0); PG8_BAR; PG8_MMA(0, 0, At, B0); PG8_MMA(0, 1, At, B1); PG8_BAR; PG8_SCHED;
            PG8_LDA(At, 1, 1); PG8_STAGE(PG8_SB(1, 0), b3, voffB); PG8_STAGE(PG8_SB(1, 1), b3 + hstep, voffB); PG8_STAGE(PG8_SA(1, 0), a3, voffA);
            PG8_WAIT_V(8); PG8_WAIT_L(0); PG8_BAR; PG8_MMA(1, 0, At, B0); PG8_MMA(1, 1, At, B1); PG8_BAR; PG8_SCHED;
            } else {
            PG8_LDB(B0, 0, 0); PG8_SCHED; PG8_LDA(At, 0, 0); PG8_STAGE(PG8_SA(1, 1), a1 + hstep, voffA);
            PG8_WAIT_L(8); PG8_BAR; PG8_WAIT_L(0); PG8_MMA(0, 0, At, B0); PG8_BAR; PG8_SCHED;
            PG8_LDB(B1, 0, 1); PG8_STAGE(PG8_SB(0, 0), b2, voffB);
            PG8_BAR; PG8_WAIT_L(0); PG8_MMA(0, 1, At, B1); PG8_BAR;
            PG8_LDA(At, 0, 1); PG8_STAGE(PG8_SA(0, 0), a2, voffA);
            PG8_BAR; PG8_WAIT_L(0); PG8_MMA(1, 0, At, B0); PG8_BAR; PG8_SCHED;
            PG8_STAGE(PG8_SB(0, 1), b2 + hstep, voffB);
            PG8_WAIT_V(6); PG8_BAR; PG8_MMA(1, 1, At, B1); PG8_BAR;
            PG8_LDB(B0, 1, 0); PG8_SCHED; PG8_LDA(At, 1, 0); PG8_STAGE(PG8_SA(0, 1), a2 + hstep, voffA);
            PG8_WAIT_L(8); PG8_BAR; PG8_WAIT_L(0); PG8_MMA(0, 0, At, B0); PG8_BAR; PG8_SCHED;
            PG8_LDB(B1, 1, 1); PG8_STAGE(PG8_SB(1, 0), b3, voffB);
            PG8_BAR; PG8_WAIT_L(0); PG8_MMA(0, 1, At, B1); PG8_BAR;
            PG8_LDA(At, 1, 1); PG8_STAGE(PG8_SA(1, 0), a3, voffA);
            PG8_BAR; PG8_WAIT_L(0); PG8_MMA(1, 0, At, B0); PG8_BAR; PG8_SCHED;
            PG8_STAGE(PG8_SB(1, 1), b3 + hstep, voffB);
            PG8_WAIT_V(6); PG8_BAR; PG8_MMA(1, 1, At, B1); PG8_BAR;
            }
        }
        if constexpr (ALIGN_EPI) { if (wr == 0) PG8_BAR; }
        E(acc, cur, wr, wc, fr, fq); S.done(cur);
        if (!has_next) break;
#pragma unroll
        for (int a = 0; a < 2; ++a)
#pragma unroll
            for (int b = 0; b < 2; ++b)
#pragma unroll
                for (int m = 0; m < 4; ++m)
#pragma unroll
                    for (int n = 0; n < 2; ++n) acc[a][b][m][n] = (f32x4){0.f, 0.f, 0.f, 0.f};
        cur = nxt; cA = nA; cB = nB; ++ui;
        if constexpr (ALIGN_EPI) { if (wr == 1) PG8_BAR; }
    }
    PG8_WAIT_V(0);
    if constexpr (!ALIGN_EPI) { if (wr == 0) PG8_BAR; }
    PG8_BAR;
#undef PG8_SA
#undef PG8_SB
#undef PG8_STAGE
#undef PG8_LDA
#undef PG8_LDB
#undef PG8_MMA
#undef PG8_WAIT_V
#undef PG8_WAIT_L
#undef PG8_BAR
#undef PG8_SCHED
}
}

constexpr int NWAVES = 8;
constexpr int DM = 2048, BATCH = 8, SEQ = 2048, NMETA = 16, TT = SEQ + NMETA, M = BATCH * SEQ, DIN = 12800;
constexpr int OFF_GR = 2048, OFF_Q = 4096, OFF_K = 6144, OFF_V = 6400, OFF_GA = 6656, OFF_G = 8704;
constexpr int DKV = 256, NKV = 4, GROUP = 8, HD = 64;
constexpr float LN_EPS = 1e-5f;
constexpr float DN_ALPHA = 1.189207115002721f;
constexpr float LOG2E = 1.4426950408889634f;
constexpr float QSCALE = 0.125f * LOG2E;

constexpr size_t MiB = 1u << 20;
constexpr size_t WS_CTL = 0, CTL_ZERO_BYTES = 1 * MiB;
constexpr size_t WS_STATS = 1 * MiB;
constexpr size_t WS_ROPE = 1 * MiB + 256 * 1024;
constexpr size_t WS_KVMETA = 1 * MiB + 832 * 1024;
constexpr size_t WS_LNP = 2 * MiB;
constexpr size_t WS_WG = 6 * MiB;
constexpr size_t WS_WIN = 8 * MiB;
constexpr size_t WS_WY = 58 * MiB;
constexpr size_t WS_WO = 74 * MiB;
constexpr size_t WS_XR = 82 * MiB;
constexpr size_t WS_K = 148 * MiB, WS_V = 156 * MiB;
constexpr size_t WS_AC = 164 * MiB;
constexpr size_t WS_MG = 292 * MiB;
constexpr size_t WS_MIX = 420 * MiB;
constexpr size_t WS_END = 484 * MiB;
constexpr size_t OUT_H = 0, OUT_Q = 64 * MiB;

constexpr int CW_TMO = 0, CW_CODE = 1, CW_BAR = 4096;

constexpr int RING_BYTES = 131072, LDSCTL_OFF = RING_BYTES, MISC_OFF = LDSCTL_OFF + 320, LDS_BYTES = 147456;

#define GAS __attribute__((address_space(1)))
#define LAS __attribute__((address_space(3)))
typedef unsigned short bf16;
typedef unsigned v4u __attribute__((ext_vector_type(4)));
typedef unsigned v2u __attribute__((ext_vector_type(2)));
typedef float f32x4 __attribute__((ext_vector_type(4)));
typedef float f32x2 __attribute__((ext_vector_type(2)));
typedef float f32x16 __attribute__((ext_vector_type(16)));
typedef short bf16x8 __attribute__((ext_vector_type(8)));
typedef short s16x4 __attribute__((ext_vector_type(4)));
typedef GAS unsigned gu32;
#define RLX_AGENT __ATOMIC_RELAXED, __HIP_MEMORY_SCOPE_AGENT
#define LDS_WAIT() asm volatile("s_waitcnt lgkmcnt(0)" ::: "memory")
#define VM_WAIT() asm volatile("s_waitcnt vmcnt(0)" ::: "memory")
__device__ __forceinline__ unsigned f2bf(float f) { unsigned u = __builtin_bit_cast(unsigned, f); return (u + 0x7fffu + ((u >> 16) & 1u)) >> 16; }
typedef __bf16 bf16x2_t __attribute__((ext_vector_type(2)));
__device__ __forceinline__ unsigned pk2(float lo, float hi) { const float __attribute__((ext_vector_type(2))) v = {lo, hi}; return __builtin_bit_cast(unsigned, __builtin_convertvector(v, bf16x2_t)); }
__device__ __forceinline__ float bf_lo(unsigned w) { return __builtin_bit_cast(float, w << 16); }
__device__ __forceinline__ float bf_hi(unsigned w) { return __builtin_bit_cast(float, w & 0xffff0000u); }
__device__ __forceinline__ float sigmoidf_fast(float x) { return __builtin_amdgcn_rcpf(1.f + __expf(-x)); }

#define XB_TMO      128
#define XB_XCNT(j)  (256  + 64 * (j))
#define XB_XSUB(j)  (1280 + 64 * (j))
#define XB_XGEN(j)  (2304 + 64 * (j))
#define XB_TOP      3328
#define XB_TOPGEN   3392
#define XCD_BAR_WORDS 3456
#define XB_SPIN_CAP (1u << 18)
__device__ __forceinline__ unsigned xb_ld(unsigned* p)              { return __hip_atomic_load(p, __ATOMIC_RELAXED, __HIP_MEMORY_SCOPE_AGENT); }
__device__ __forceinline__ unsigned xb_add(unsigned* p, unsigned v) { return __hip_atomic_fetch_add(p, v, __ATOMIC_RELAXED, __HIP_MEMORY_SCOPE_AGENT); }
__device__ __forceinline__ unsigned xb_xcc_id() { return (unsigned)__builtin_amdgcn_s_getreg((3 << 11) | 20) & 0xFu; }
#define XB_SPIN(cond, bar) do { unsigned _sp = 0; while (cond) { __builtin_amdgcn_s_sleep(1); \
    if ((++_sp & 255u) == 0u) { if (xb_ld(&(bar)[XB_TMO])) break; if (_sp > XB_SPIN_CAP) { atomicAdd(&(bar)[XB_TMO], 1u); break; } } } } while (0)
struct XcdBarrier { unsigned* bar; unsigned x; volatile LAS unsigned* st; };
__device__ __forceinline__ XcdBarrier xcd_barrier_post(unsigned* bar, volatile LAS unsigned* st) {
    XcdBarrier b; b.bar = bar; b.x = xb_xcc_id(); b.st = st;
    if (threadIdx.x == 0) (void)xb_add(&bar[XB_XCNT(b.x)], 1u);
    return b;
}
__device__ __forceinline__ void xcd_barrier_complete(unsigned* bar, unsigned x, unsigned& nloc, unsigned& nx) {
    const unsigned G = gridDim.x * gridDim.y * gridDim.z;
    unsigned sum, cnt, mine, sp = 0u;
    for (;;) {
        sum = 0u; cnt = 0u; mine = 0u;
#pragma unroll
        for (unsigned j = 0; j < 16; ++j) { const unsigned c = xb_ld(&bar[XB_XCNT(j)]); sum += c; cnt += (c > 0u) ? 1u : 0u; mine = (j == x) ? c : mine; }
        if (sum == G) break;
        __builtin_amdgcn_s_sleep(1);
        if ((++sp & 255u) == 0u) { if (xb_ld(&bar[XB_TMO])) break; if (sp > XB_SPIN_CAP) { atomicAdd(&bar[XB_TMO], 1u); break; } }
    }
    nloc = mine > 0u ? mine : 1u; nx = cnt > 0u ? cnt : 1u;
}
__device__ __forceinline__ void xcd_barrier(const XcdBarrier& b) {
    asm volatile("s_waitcnt vmcnt(0)" ::: "memory");
    __syncthreads();
    if (threadIdx.x == 0) {
        unsigned* bar = b.bar;
        __builtin_amdgcn_s_waitcnt(0);
        unsigned nloc = b.st[0], nx = b.st[1];
        if (nloc == 0u) { xcd_barrier_complete(bar, b.x, nloc, nx); b.st[0] = nloc; b.st[1] = nx; }
        const unsigned old = xb_add(&bar[XB_XSUB(b.x)], 1u);
        const unsigned gen = old / nloc;
        if (old + 1u == (gen + 1u) * nloc) {
            __builtin_amdgcn_fence(__ATOMIC_RELEASE, "agent");
            asm volatile("s_waitcnt vmcnt(0)" ::: "memory");
            const unsigned og = xb_add(&bar[XB_TOP], 1u);
            const unsigned tg = og / nx;
            if (og + 1u == (tg + 1u) * nx) xb_add(&bar[XB_TOPGEN], 1u);
            else XB_SPIN(xb_ld(&bar[XB_TOPGEN]) == tg, bar);
            __builtin_amdgcn_fence(__ATOMIC_ACQUIRE, "agent");
            xb_add(&bar[XB_XGEN(b.x)], 1u);
            asm volatile("s_waitcnt vmcnt(0)" ::: "memory");
        } else {
            XB_SPIN(xb_ld(&bar[XB_XGEN(b.x)]) == gen, bar);
            __builtin_amdgcn_fence(__ATOMIC_ACQUIRE, "agent");
            asm volatile("s_waitcnt vmcnt(0)" ::: "memory");
        }
    }
    __syncthreads();
}

struct Frame {
    LAS unsigned char* lds;
    volatile LAS unsigned* MISC;
    gu32* ctl;
    int tid, lane, wave, vcu, G;
    const float *x, *meta, *lne_g, *lne_b, *w_in, *b_in, *conv_w, *conv_b, *w_ra, *b_ra, *w_ri, *b_ri, *lam, *sinks, *w_rnn, *w_attn, *w_o, *b_o, *ln_g, *ln_b;
    float* out;
    unsigned char* ws;
};
__device__ __forceinline__ float wave_sum(float v) {
#pragma unroll
    for (int o = 1; o < 64; o <<= 1) v += __shfl_xor(v, o);
    return v;
}

template <class RowFn>
__device__ __forceinline__ void p0_transpose_item(const float* W, int ldw, bf16* WT, int ldk, int koff, LAS float* scr, int k0, int n0, int lane, RowFn rowfn) {
#pragma unroll 8
    for (int i = 0; i < 32; ++i) { const int kk = 2 * i + (lane >> 5); scr[kk * 33 + (lane & 31)] = W[(size_t)(k0 + kk) * ldw + n0 + (lane & 31)]; }
    LDS_WAIT(); asm volatile("" ::: "memory");
    const int c = lane & 7;
#pragma unroll
    for (int j = 0; j < 4; ++j) { const int n = (lane >> 3) + 8 * j; const LAS float* s = scr + (8 * c) * 33 + n;
        v4u o; o.x = pk2(s[0 * 33], s[1 * 33]); o.y = pk2(s[2 * 33], s[3 * 33]); o.z = pk2(s[4 * 33], s[5 * 33]); o.w = pk2(s[6 * 33], s[7 * 33]);
        *(GAS v4u*)(WT + (size_t)rowfn(n0 + n) * ldk + koff + k0 + 8 * c) = o; }
    LDS_WAIT(); asm volatile("" ::: "memory");
}
__device__ __forceinline__ int win_row(int c) { const int pn = c >> 8, L = c & 255; return (pn << 8) + (((L >> 5) & 1) << 7) + ((L >> 6) << 5) + (L & 31); }
__device__ __forceinline__ int wg_row(int d, int g) { const int q = d >> 6, cq = d & 63, w = cq >> 3, e = cq & 7; return q * 128 + w * 16 + (e >> 1) * 4 + g * 2 + (e & 1); }

__device__ __forceinline__ void ln_row_to_bf16(const float* xrow, const float* g, const float* be, bf16* orow, float* stat, int lane) {
    const GAS f32x4* xr = (const GAS f32x4*)xrow + lane;
    f32x4 v[8]; float s = 0.f;
#pragma unroll
    for (int j = 0; j < 8; ++j) { v[j] = xr[64 * j]; s += (v[j].x + v[j].y) + (v[j].z + v[j].w); }
    const float mean = wave_sum(s) * (1.f / DM); float s2 = 0.f;
#pragma unroll
    for (int j = 0; j < 8; ++j) { v[j] = v[j] - mean; s2 += (v[j].x * v[j].x + v[j].y * v[j].y) + (v[j].z * v[j].z + v[j].w * v[j].w); }
    const float rstd = 1.f / sqrtf(wave_sum(s2) * (1.f / DM) + LN_EPS);
    if (stat && lane == 0) { stat[0] = mean; stat[1] = rstd; }
    GAS unsigned long long* o8 = (GAS unsigned long long*)orow + lane;
#pragma unroll
    for (int j = 0; j < 8; ++j) { const f32x4 gg = *((const GAS f32x4*)g + lane + 64 * j), bb = *((const GAS f32x4*)be + lane + 64 * j);
        const f32x4 y = v[j] * rstd * gg + bb;
        o8[64 * j] = (unsigned long long)pk2(y.x, y.y) | ((unsigned long long)pk2(y.z, y.w) << 32); }
}

__device__ __forceinline__ void p0_meta(Frame& F, int grp) {
    LAS float* hm = (LAS float*)F.lds;
    for (int r = F.wave * 2; r < F.wave * 2 + 2; ++r) {
        const GAS f32x4* xr = (const GAS f32x4*)(F.meta + (size_t)r * DM) + F.lane;
        f32x4 v[8]; float s = 0.f;
#pragma unroll
        for (int j = 0; j < 8; ++j) { v[j] = xr[64 * j]; s += (v[j].x + v[j].y) + (v[j].z + v[j].w); }
        const float mean = wave_sum(s) * (1.f / DM); float s2 = 0.f;
#pragma unroll
        for (int j = 0; j < 8; ++j) { v[j] = v[j] - mean; s2 += (v[j].x * v[j].x + v[j].y * v[j].y) + (v[j].z * v[j].z + v[j].w * v[j].w); }
        const float rstd = 1.f / sqrtf(wave_sum(s2) * (1.f / DM) + LN_EPS);
#pragma unroll
        for (int j = 0; j < 8; ++j) { const f32x4 gg = *((const GAS f32x4*)F.lne_g + F.lane + 64 * j), bb = *((const GAS f32x4*)F.lne_b + F.lane + 64 * j);
            f32x4 y = v[j] * rstd * gg + bb;
            y.x = bf_lo(f2bf(y.x)); y.y = bf_lo(f2bf(y.y)); y.z = bf_lo(f2bf(y.z)); y.w = bf_lo(f2bf(y.w));
            *((LAS f32x4*)(hm + r * DM) + F.lane + 64 * j) = y; }
    }
    LDS_WAIT(); __syncthreads();
    const int colbase = grp < 32 ? 64 * grp : (grp < 36 ? OFF_K + 64 * (grp - 32) : OFF_V + 64 * (grp - 36));
    const int col = colbase + F.lane, ks = F.wave;
    float acc[16];
#pragma unroll
    for (int r = 0; r < 16; ++r) acc[r] = 0.f;
    const float* wp = F.w_in + (size_t)(ks * 256) * DIN + col;
    for (int k = 0; k < 256; k += 4) {
        float w0 = wp[(size_t)(k + 0) * DIN], w1 = wp[(size_t)(k + 1) * DIN], w2 = wp[(size_t)(k + 2) * DIN], w3 = wp[(size_t)(k + 3) * DIN];
        w0 = bf_lo(f2bf(w0)); w1 = bf_lo(f2bf(w1)); w2 = bf_lo(f2bf(w2)); w3 = bf_lo(f2bf(w3));
#pragma unroll
        for (int r = 0; r < 16; ++r) { const f32x4 h4 = *(const LAS f32x4*)(hm + r * DM + ks * 256 + k); acc[r] += h4.x * w0 + h4.y * w1 + h4.z * w2 + h4.w * w3; }
    }
    __syncthreads();
    LAS float* red = (LAS float*)F.lds;
#pragma unroll
    for (int r = 0; r < 16; ++r) red[(ks * 16 + r) * 64 + F.lane] = acc[r];
    LDS_WAIT(); __syncthreads();
    LAS float* zz = red + 8 * 16 * 64;
    for (int pass = 0; pass < 2; ++pass) { const int o = F.tid + 512 * pass, r = o >> 6, c = o & 63; float s = F.b_in[colbase + c];
#pragma unroll
        for (int k8 = 0; k8 < 8; ++k8) s += red[(k8 * 16 + r) * 64 + c];
        zz[r * 64 + c] = s; }
    LDS_WAIT(); __syncthreads();
    const float* cosT = (const float*)(F.ws + WS_ROPE); const float* sinT = cosT + TT * 32;
    for (int pass = 0; pass < 2; ++pass) { const int o = F.tid + 512 * pass, r = o >> 6, c = o & 63; const float v = zz[r * 64 + c];
        if (grp < 32) { const unsigned short b16 = (unsigned short)f2bf(v);
            for (int b = 0; b < BATCH; ++b) ((bf16*)(F.ws + WS_XR))[(size_t)(b * TT + r) * DM + colbase + c] = b16; }
        else if (grp < 36) { const int d = c & 31; const float x1 = zz[r * 64 + d], x2 = zz[r * 64 + 32 + d];
            const float inv = (float)pow(10000.0, -(double)d / 32.0); const float ang = (float)r * inv; const float cs = (float)cos((double)ang), sn = (float)sin((double)ang);
            const float y = (c < 32) ? (x1 * cs - x2 * sn) : (x2 * cs + x1 * sn);
            ((bf16*)(F.ws + WS_KVMETA))[r * DKV + (grp - 32) * 64 + c] = (unsigned short)f2bf(y); (void)cosT; (void)sinT; }
        else ((bf16*)(F.ws + WS_KVMETA))[16 * DKV + r * DKV + (grp - 36) * 64 + c] = (unsigned short)f2bf(v);
    }
    __syncthreads();
}

__device__ __forceinline__ void p0_prologue(Frame& F) {
    LAS float* scr = (LAS float*)(F.lds + F.wave * 16384);
    const int gw = F.vcu * NWAVES + F.wave, NGW = F.G * NWAVES;
    constexpr int I_IN = (DM / 64) * (DIN / 32), I_SQ = (DM / 64) * (DM / 32), I_G = 8 * (256 / 64) * (256 / 32);
    constexpr int NITEMS = I_IN + 3 * I_SQ + 2 * I_G;
    for (int it = gw; it < NITEMS; it += NGW) {
        int r = it;
        if (r < I_IN) { const int nblk = DIN / 32, kb = r / nblk, nb = r % nblk;
            p0_transpose_item(F.w_in, DIN, (bf16*)(F.ws + WS_WIN), DM, 0, scr, 64 * kb, 32 * nb, F.lane, [](int n) { return win_row(n); }); continue; } r -= I_IN;
        if (r < I_SQ) { const int kb = r / 64, nb = r % 64; p0_transpose_item(F.w_rnn, DM, (bf16*)(F.ws + WS_WY), 2 * DM, 0, scr, 64 * kb, 32 * nb, F.lane, [](int n) { return n; }); continue; } r -= I_SQ;
        if (r < I_SQ) { const int kb = r / 64, nb = r % 64; p0_transpose_item(F.w_attn, DM, (bf16*)(F.ws + WS_WY), 2 * DM, DM, scr, 64 * kb, 32 * nb, F.lane, [](int n) { return n; }); continue; } r -= I_SQ;
        if (r < I_SQ) { const int kb = r / 64, nb = r % 64; p0_transpose_item(F.w_o, DM, (bf16*)(F.ws + WS_WO), DM, 0, scr, 64 * kb, 32 * nb, F.lane, [](int n) { return n; }); continue; } r -= I_SQ;
        { const int g = r / I_G, rr = r % I_G, blk = rr / 32, kb = (rr % 32) / 8, nb = rr % 8; const float* W = (g ? F.w_ri : F.w_ra) + (size_t)blk * 65536;
          p0_transpose_item(W, 256, (bf16*)(F.ws + WS_WG) + (size_t)blk * 512 * 256, 256, 0, scr, 64 * kb, 32 * nb, F.lane, [g](int n) { return wg_row(n, g); }); }
    }
    bf16* H = (bf16*)((unsigned char*)F.out + OUT_H); float* stats = (float*)(F.ws + WS_STATS);
    for (int m = gw; m < M; m += NGW) ln_row_to_bf16(F.x + (size_t)m * DM, F.lne_g, F.lne_b, H + (size_t)m * DM, stats + 2 * m, F.lane);
    { float* cosT = (float*)(F.ws + WS_ROPE); float* sinT = cosT + TT * 32;
      for (int i = (F.vcu * NWAVES + F.wave) * 64 + F.lane; i < TT * 32; i += NGW * 64) { const int p = i >> 5, d = i & 31;
          const float inv = (float)pow(10000.0, -(double)d / 32.0); const float ang = (float)p * inv; cosT[i] = (float)cos((double)ang); sinT[i] = (float)sin((double)ang); } }
    __syncthreads();
    if (F.vcu >= F.G - 40) p0_meta(F, F.vcu - (F.G - 40));
}

struct EpiZ {
    static constexpr bool PERM = true, HAS_MID = false;
    const float* bias; const float* cosT; const float* sinT; bf16 *XR, *AC, *Q, *Kb, *Vb, *MG;
    __device__ __forceinline__ void operator()(const f32x4 (&acc)[2][2][4][2], const pg8::Unit& u, int wr, int wc, int fr, int fq) const {
        const int pn = u.pn; const int row0 = u.pm * 256 + wr * 64 + fr;
        const int lc0 = pn * 256 + wc * 64 + 8 * fq;
        f32x4 bv[2][2];
#pragma unroll
        for (int bj = 0; bj < 2; ++bj)
#pragma unroll
            for (int n = 0; n < 2; ++n) bv[bj][n] = *(const f32x4*)(bias + lc0 + 32 * bj + 4 * n);
        if (pn >= 16 && pn < 25) {
            const bool isq = pn < 24; bf16* dst = isq ? Q : Kb; const int pitch = isq ? DM : DKV; const int cb = (isq ? (pn - 16) * 256 : 0) + wc * 64 + 8 * fq; const float sc = isq ? QSCALE : 1.f;
#pragma unroll
            for (int ai = 0; ai < 2; ++ai)
#pragma unroll
                for (int m = 0; m < 4; ++m) { const int row = row0 + ai * 128 + m * 16; const int pos = NMETA + (row & (SEQ - 1));
                    const f32x4 c0 = *(const f32x4*)(cosT + pos * 32 + 8 * fq), c1 = *(const f32x4*)(cosT + pos * 32 + 8 * fq + 4), s0 = *(const f32x4*)(sinT + pos * 32 + 8 * fq), s1 = *(const f32x4*)(sinT + pos * 32 + 8 * fq + 4);
                    const f32x4 a0 = acc[ai][0][m][0] + bv[0][0], a1 = acc[ai][0][m][1] + bv[0][1], b0 = acc[ai][1][m][0] + bv[1][0], b1 = acc[ai][1][m][1] + bv[1][1];
                    const f32x4 y0 = (a0 * c0 - b0 * s0) * sc, y1 = (a1 * c1 - b1 * s1) * sc, z0 = (b0 * c0 + a0 * s0) * sc, z1 = (b1 * c1 + a1 * s1) * sc;
                    v4u w; w.x = pk2(y0[0], y0[1]); w.y = pk2(y0[2], y0[3]); w.z = pk2(y1[0], y1[1]); w.w = pk2(y1[2], y1[3]);
                    *(GAS v4u*)(dst + (size_t)row * pitch + cb) = w;
                    w.x = pk2(z0[0], z0[1]); w.y = pk2(z0[2], z0[3]); w.z = pk2(z1[0], z1[1]); w.w = pk2(z1[2], z1[3]);
                    *(GAS v4u*)(dst + (size_t)row * pitch + cb + 32) = w; }
            return;
        }
        int act, pitch, cb; bf16* dst; int rowadd = 0;
        if (pn < 8) { act = 0; dst = XR; pitch = DM; cb = lc0; rowadd = 1; }
        else if (pn < 16) { act = 1; dst = AC; pitch = 2 * DM; cb = lc0 - OFF_GR; }
        else if (pn == 25) { act = 0; dst = Vb; pitch = DKV; cb = lc0 - OFF_V; }
        else if (pn < 34) { act = 1; dst = AC; pitch = 2 * DM; cb = DM + lc0 - OFF_GA; }
        else { act = 2; dst = MG; pitch = 2 * DM; cb = lc0 - OFF_G; }
#pragma unroll
        for (int ai = 0; ai < 2; ++ai)
#pragma unroll
            for (int m = 0; m < 4; ++m) { const int row = row0 + ai * 128 + m * 16; const size_t orow = rowadd ? (size_t)(row + NMETA * ((row >> 11) + 1)) : (size_t)row;
#pragma unroll
                for (int bj = 0; bj < 2; ++bj) { f32x4 v0 = acc[ai][bj][m][0] + bv[bj][0], v1 = acc[ai][bj][m][1] + bv[bj][1];
                    if (act == 1) {
#pragma unroll
                        for (int j = 0; j < 4; ++j) { v0[j] = v0[j] * sigmoidf_fast(v0[j]); v1[j] = v1[j] * sigmoidf_fast(v1[j]); } }
                    else if (act == 2) {
#pragma unroll
                        for (int j = 0; j < 4; ++j) { v0[j] = sigmoidf_fast(v0[j]); v1[j] = sigmoidf_fast(v1[j]); } }
                    v4u w; w.x = pk2(v0[0], v0[1]); w.y = pk2(v0[2], v0[3]); w.z = pk2(v1[0], v1[1]); w.w = pk2(v1[2], v1[3]);
                    *(GAS v4u*)(dst + orow * pitch + cb + 32 * bj) = w; } }
    }
};

constexpr int XC_PITCH = 528;
template <int CTRL> __device__ __forceinline__ float dpp_f(float oldv, float src) {
    return __builtin_bit_cast(float, __builtin_amdgcn_update_dpp(__builtin_bit_cast(int, oldv), __builtin_bit_cast(int, src), CTRL, 0xF, 0xF, false)); }
__device__ __forceinline__ float bcast15(float v) { const float a = dpp_f<0xFF>(v, v); const float b = dpp_f<0x104>(a, a); return dpp_f<0x108>(b, b); }
#define SCAN_STEP(S_) do { const float Ap0 = dpp_f<0x110 + S_>(1.f, A0), Bp0 = dpp_f<0x110 + S_>(0.f, B0), Ap1 = dpp_f<0x110 + S_>(1.f, A1), Bp1 = dpp_f<0x110 + S_>(0.f, B1); \
    B0 = A0 * Bp0 + B0; A0 = A0 * Ap0; B1 = A1 * Bp1 + B1; A1 = A1 * Ap1; } while (0)

__device__ __forceinline__ void p2_scan_item(Frame& F, int item) {
    const int b = item >> 5, nb = (item >> 2) & 7, q = item & 3;
    const int tid = F.tid, lane = F.lane, w = F.wave, fr = lane & 15, fq = lane >> 4;
    const bf16* XR = (const bf16*)(F.ws + WS_XR) + (size_t)b * TT * DM + nb * 256;
    bf16* AC = (bf16*)(F.ws + WS_AC);
    LAS unsigned char* xcl = F.lds;
    bf16x8 wf[8];
    { const bf16* wg = (const bf16*)(F.ws + WS_WG) + ((size_t)nb * 512 + q * 128 + w * 16 + fr) * 256 + 8 * fq;
#pragma unroll
      for (int ks = 0; ks < 8; ++ks) wf[ks] = *(const GAS bf16x8*)(wg + 32 * ks); }
    const int cg = tid & 31, oct = tid >> 5;
    float cw[4][8], cbv[8];
    { const int gch = nb * 256 + 8 * cg;
#pragma unroll
      for (int k = 0; k < 4; ++k) { const f32x4 a = *(const GAS f32x4*)(F.conv_w + k * DM + gch), bq = *(const GAS f32x4*)(F.conv_w + k * DM + gch + 4);
          cw[k][0] = a.x; cw[k][1] = a.y; cw[k][2] = a.z; cw[k][3] = a.w; cw[k][4] = bq.x; cw[k][5] = bq.y; cw[k][6] = bq.z; cw[k][7] = bq.w; }
      const f32x4 a = *(const GAS f32x4*)(F.conv_b + gch), bq = *(const GAS f32x4*)(F.conv_b + gch + 4);
      cbv[0] = a.x; cbv[1] = a.y; cbv[2] = a.z; cbv[3] = a.w; cbv[4] = bq.x; cbv[5] = bq.y; cbv[6] = bq.z; cbv[7] = bq.w; }
    const int chl = 64 * q + 8 * w + 2 * fq, gch0 = nb * 256 + chl;
    const float bra0 = F.b_ra[gch0], bra1 = F.b_ra[gch0 + 1], bri0 = F.b_ri[gch0], bri1 = F.b_ri[gch0 + 1];
    const float c80 = -8.f * log1pf(expf(-F.lam[gch0])), c81 = -8.f * log1pf(expf(-F.lam[gch0 + 1]));
    float hin0 = 0.f, hin1 = 0.f;
    bf16* acp = AC + (size_t)(b * SEQ + fr - NMETA) * (2 * DM) + gch0;
    v4u xrow[11];
#define LOAD_ROWS(c_) do { _Pragma("unroll") for (int i = 0; i < 11; ++i) { int p = 128 * (c_) + 8 * oct - 3 + i; const bool ok = p >= 0; p = p < 0 ? 0 : (p > TT - 1 ? TT - 1 : p); \
            v4u v = *(const GAS v4u*)(XR + (size_t)p * DM + 8 * cg); if (!ok) v = (v4u){0u, 0u, 0u, 0u}; xrow[i] = v; } } while (0)
    LOAD_ROWS(0);
    constexpr int NCH = 17;
    for (int c = 0; c < NCH; ++c) {
        unsigned grw[8];
#pragma unroll
        for (int mt = 0; mt < 8; ++mt) { const int p0 = 128 * c + 16 * mt; grw[mt] = 0u;
            if (p0 >= NMETA && p0 < TT) grw[mt] = *(const GAS unsigned*)(acp + (size_t)p0 * (2 * DM)); }
        { float xf[11][8];
#pragma unroll
          for (int i = 0; i < 11; ++i) { const v4u r = xrow[i]; xf[i][0] = bf_lo(r.x); xf[i][1] = bf_hi(r.x); xf[i][2] = bf_lo(r.y); xf[i][3] = bf_hi(r.y); xf[i][4] = bf_lo(r.z); xf[i][5] = bf_hi(r.z); xf[i][6] = bf_lo(r.w); xf[i][7] = bf_hi(r.w); }
#pragma unroll
          for (int e = 0; e < 8; ++e) {
            float y[8];
#pragma unroll
            for (int j = 0; j < 8; ++j) y[j] = cbv[j] + cw[0][j] * xf[e + 3][j] + cw[1][j] * xf[e + 2][j] + cw[2][j] * xf[e + 1][j] + cw[3][j] * xf[e][j];
            v4u o; o.x = pk2(y[0], y[1]); o.y = pk2(y[2], y[3]); o.z = pk2(y[4], y[5]); o.w = pk2(y[6], y[7]);
            *(LAS v4u*)(xcl + (8 * oct + e) * XC_PITCH + 16 * cg) = o;
          } }
        if (c + 1 < NCH) LOAD_ROWS(c + 1);
        LDS_WAIT(); __syncthreads();
        const int nmt = (c == NCH - 1) ? 1 : 8;
#pragma unroll
        for (int mt = 0; mt < 8; ++mt) { if (mt < nmt) {
            const int p0 = 128 * c + 16 * mt;
            pg8::f32x4 acc = (pg8::f32x4){0.f, 0.f, 0.f, 0.f};
#pragma unroll
            for (int ks = 0; ks < 8; ++ks) { const bf16x8 xf = *(const LAS bf16x8*)(xcl + (16 * mt + fr) * XC_PITCH + 64 * ks + 16 * fq);
                acc = __builtin_amdgcn_mfma_f32_16x16x32_bf16(wf[ks], xf, acc, 0, 0, 0); }
            const unsigned xcw = *(const LAS unsigned*)(xcl + (16 * mt + fr) * XC_PITCH + 2 * chl);
            const float xc0 = bf_lo(xcw), xc1 = bf_hi(xcw);
            const float gr0 = sigmoidf_fast(acc[0] + bra0), gr1 = sigmoidf_fast(acc[1] + bra1), gi0 = sigmoidf_fast(acc[2] + bri0), gi1 = sigmoidf_fast(acc[3] + bri1);
            const float la0 = gr0 * c80, la1 = gr1 * c81;
            float A0 = __expf(la0), A1 = __expf(la1);
            const float x20 = 2.f * la0, x21 = 2.f * la1;
            const float sr0 = -x20 * (1.f + x20 * (0.5f + x20 * (0.16666667f + x20 * 0.041666668f))), sr1 = -x21 * (1.f + x21 * (0.5f + x21 * (0.16666667f + x21 * 0.041666668f)));
            const float em0 = x20 > -0.05f ? sr0 : 1.f - A0 * A0, em1 = x21 > -0.05f ? sr1 : 1.f - A1 * A1;
            float mu0 = __builtin_amdgcn_sqrtf(em0), mu1 = __builtin_amdgcn_sqrtf(em1); if (p0 + fr == 0) { mu0 = 1.f; mu1 = 1.f; }
            float B0 = mu0 * gi0 * xc0, B1 = mu1 * gi1 * xc1;
            SCAN_STEP(1); SCAN_STEP(2); SCAN_STEP(4); SCAN_STEP(8);
            const float h0 = A0 * hin0 + B0, h1 = A1 * hin1 + B1;
            const float At0 = bcast15(A0), Bt0 = bcast15(B0), At1 = bcast15(A1), Bt1 = bcast15(B1);
            hin0 = At0 * hin0 + Bt0; hin1 = At1 * hin1 + Bt1;
            if (p0 >= NMETA) *(GAS unsigned*)(acp + (size_t)p0 * (2 * DM)) = pk2(h0 * bf_lo(grw[mt]), h1 * bf_hi(grw[mt]));
        } }
        __syncthreads();
    }
#undef LOAD_ROWS
}

constexpr int NKEY = 288;
constexpr int KCH = NKEY * 16 + 16;
constexpr int ATT_K = 0, ATT_V = 8 * KCH, ATT_VH = NKEY * 64, ATT_WS = ATT_V + 2 * ATT_VH, ATT_OST = ATT_WS + NWAVES * 256, ATT_BYTES = ATT_OST + NWAVES * 4096;
static_assert(ATT_BYTES <= RING_BYTES && (ATT_V % 16) == 0 && (ATT_OST % 16) == 0, "attention LDS map");
__device__ __forceinline__ int crow(int r, int hi) { return (r & 3) + 8 * (r >> 2) + 4 * hi; }
__device__ __forceinline__ s16x4 vtr(const LAS unsigned char* p) { typedef short v4i16_t __attribute__((ext_vector_type(4))); return __builtin_bit_cast(s16x4, __builtin_amdgcn_ds_read_tr16_b64_v4i16((LAS v4i16_t*)p)); }

__device__ __forceinline__ void p2_attn_item(Frame& F, int item) {
    const int b = item >> 6, kvh = (item >> 4) & 3, jb = item & 15;
    const int tid = F.tid, lane = F.lane, w = F.wave, r32 = lane & 31, hi = lane >> 5;
    const bf16* Kg = (const bf16*)(F.ws + WS_K); const bf16* Vg = (const bf16*)(F.ws + WS_V); const bf16* KVm = (const bf16*)(F.ws + WS_KVMETA);
    const bf16* Qg = (const bf16*)((unsigned char*)F.out + OUT_Q); bf16* AC = (bf16*)(F.ws + WS_AC);
    LAS unsigned char* L = F.lds;
    const int hq = kvh * GROUP + w;
    const bf16* qp0 = Qg + (size_t)(b * SEQ + 128 * jb + r32) * DM + hq * 64 + hi * 8;
    bf16x8 qn[4];
#pragma unroll
    for (int d0 = 0; d0 < 4; ++d0) qn[d0] = *(const GAS bf16x8*)(qp0 + 16 * d0);
    { v4u kreg[5], vreg[5];
#pragma unroll
      for (int i = 0; i < 5; ++i) { const int piece = tid + 512 * i, key = piece >> 3, c = piece & 7; kreg[i] = (v4u){0u, 0u, 0u, 0u}; vreg[i] = (v4u){0u, 0u, 0u, 0u};
          if (piece < NKEY * 8) {
              if (key < 16) { kreg[i] = *(const GAS v4u*)(KVm + key * DKV + kvh * 64 + 8 * c); vreg[i] = *(const GAS v4u*)(KVm + 16 * DKV + key * DKV + kvh * 64 + 8 * c); }
              else if (key >= 32) { const int t = 128 * (jb - 1) + (key - 32);
                  if (t >= 0) { const size_t row = (size_t)(b * SEQ + t); kreg[i] = *(const GAS v4u*)(Kg + row * DKV + kvh * 64 + 8 * c); vreg[i] = *(const GAS v4u*)(Vg + row * DKV + kvh * 64 + 8 * c); } } } }
#pragma unroll
      for (int i = 0; i < 5; ++i) { const int piece = tid + 512 * i, key = piece >> 3, c = piece & 7;
          if (piece < NKEY * 8) { *(LAS v4u*)(L + ATT_K + c * KCH + key * 16) = kreg[i];
              *(LAS v4u*)(L + ATT_V + (c >> 2) * ATT_VH + (key >> 4) * 1024 + (key & 15) * 64 + (c & 3) * 16) = vreg[i]; } } }
    LDS_WAIT(); __syncthreads();
    const float sink2 = F.sinks[hq] * LOG2E;
    LAS float* wsf = (LAS float*)(L + ATT_WS) + w * 64;
    LAS bf16* stg = (LAS bf16*)(L + ATT_OST) + w * 2048;
    const LAS unsigned char* kbase = L + ATT_K + hi * KCH + r32 * 16;
    const LAS unsigned char* vbase = L + ATT_V + ((lane >> 4) & 1) * 32 + (lane & 3) * 8 + (4 * hi + ((lane & 15) >> 2)) * 64;
    const bool first = (jb == 0);
#pragma unroll 1
    for (int qs = 0; qs < 4; ++qs) {
        const int tok0 = 128 * jb + 32 * qs;
        bf16x8 qr[4];
#pragma unroll
        for (int d0 = 0; d0 < 4; ++d0) qr[d0] = qn[d0];
        if (qs < 3) {
#pragma unroll
            for (int d0 = 0; d0 < 4; ++d0) qn[d0] = *(const GAS bf16x8*)(qp0 + (size_t)(32 * (qs + 1)) * DM + 16 * d0); }
        bf16* gap = AC + (size_t)(b * SEQ + tok0 + (lane >> 3)) * (2 * DM) + DM + hq * 64 + (lane & 7) * 8;
        v4u gav[4];
#pragma unroll
        for (int i = 0; i < 4; ++i) gav[i] = *(const GAS v4u*)(gap + (size_t)(8 * i) * (2 * DM));
        f32x16 s[6];
#pragma unroll
        for (int ti = 0; ti < 6; ++ti) {
            const int krow = ti == 0 ? 0 : 32 + 32 * (qs + ti - 1);
            f32x16 a = (f32x16){0.f, 0.f, 0.f, 0.f, 0.f, 0.f, 0.f, 0.f, 0.f, 0.f, 0.f, 0.f, 0.f, 0.f, 0.f, 0.f};
#pragma unroll
            for (int d0 = 0; d0 < 4; ++d0) { const bf16x8 kf = *(const LAS bf16x8*)(kbase + (2 * d0) * KCH + krow * 16); a = __builtin_amdgcn_mfma_f32_32x32x16_bf16(kf, qr[d0], a, 0, 0, 0); }
            s[ti] = a;
        }
        const float NEG = -1e30f;
#pragma unroll
        for (int r = 0; r < 16; ++r) { const int kk = crow(r, hi);
            if (kk >= 16) s[0][r] = NEG;
            if (!(kk > r32) || first) s[1][r] = NEG;
            if (!(kk <= r32)) s[5][r] = NEG; }
        if (first) {
#pragma unroll
            for (int ti = 2; ti < 5; ++ti) if (qs + ti - 1 < 4) {
#pragma unroll
                for (int r = 0; r < 16; ++r) s[ti][r] = NEG; } }
        float mx = sink2;
#pragma unroll
        for (int ti = 0; ti < 6; ++ti)
#pragma unroll
            for (int r = 0; r < 16; ++r) mx = fmaxf(mx, s[ti][r]);
        { auto rr = __builtin_amdgcn_permlane32_swap(__float_as_uint(mx), __float_as_uint(mx), false, false); mx = fmaxf(__uint_as_float(rr[0]), __uint_as_float(rr[1])); }
        float lsum = 0.f;
#pragma unroll
        for (int ti = 0; ti < 6; ++ti)
#pragma unroll
            for (int r = 0; r < 16; ++r) { const float pv = __builtin_amdgcn_exp2f(s[ti][r] - mx); s[ti][r] = pv; lsum += pv; }
        { auto rr = __builtin_amdgcn_permlane32_swap(__float_as_uint(lsum), __float_as_uint(lsum), false, false); lsum = __uint_as_float(rr[0]) + __uint_as_float(rr[1]); }
        lsum += __builtin_amdgcn_exp2f(sink2 - mx);
        f32x16 o[2]; o[0] = (f32x16){0.f, 0.f, 0.f, 0.f, 0.f, 0.f, 0.f, 0.f, 0.f, 0.f, 0.f, 0.f, 0.f, 0.f, 0.f, 0.f}; o[1] = o[0];
#pragma unroll
        for (int ti = 0; ti < 6; ++ti) {
            const int krow = ti == 0 ? 0 : 32 + 32 * (qs + ti - 1);
            v4u pw0, pw1;
            pw0.x = pk2(s[ti][0], s[ti][1]); pw0.y = pk2(s[ti][2], s[ti][3]); pw0.z = pk2(s[ti][4], s[ti][5]); pw0.w = pk2(s[ti][6], s[ti][7]);
            pw1.x = pk2(s[ti][8], s[ti][9]); pw1.y = pk2(s[ti][10], s[ti][11]); pw1.z = pk2(s[ti][12], s[ti][13]); pw1.w = pk2(s[ti][14], s[ti][15]);
#pragma unroll
            for (int d0 = 0; d0 < 2; ++d0)
#pragma unroll
                for (int ks = 0; ks < 2; ++ks) { const LAS unsigned char* vp = vbase + d0 * ATT_VH + ((krow >> 4) + ks) * 1024;
                    const s16x4 lo = vtr(vp), hh = vtr(vp + 512);
                    const bf16x8 vf = (bf16x8){lo[0], lo[1], lo[2], lo[3], hh[0], hh[1], hh[2], hh[3]};
                    o[d0] = __builtin_amdgcn_mfma_f32_32x32x16_bf16(__builtin_bit_cast(bf16x8, ks ? pw1 : pw0), vf, o[d0], 0, 0, 0); }
        }
        if (hi == 0) wsf[r32] = lsum;
        LDS_WAIT();
#pragma unroll
        for (int r = 0; r < 16; ++r) { const int qi = crow(r, hi); const float rl = __builtin_amdgcn_rcpf(wsf[qi]);
            stg[qi * 64 + r32] = (unsigned short)f2bf(o[0][r] * rl); stg[qi * 64 + 32 + r32] = (unsigned short)f2bf(o[1][r] * rl); }
        LDS_WAIT();
#pragma unroll
        for (int i = 0; i < 4; ++i) { const int row = 8 * i + (lane >> 3), ch = lane & 7; const v4u ov = *(const LAS v4u*)(stg + row * 64 + ch * 8); const v4u g = gav[i];
            v4u res; res.x = pk2(bf_lo(ov.x) * bf_lo(g.x), bf_hi(ov.x) * bf_hi(g.x)); res.y = pk2(bf_lo(ov.y) * bf_lo(g.y), bf_hi(ov.y) * bf_hi(g.y));
            res.z = pk2(bf_lo(ov.z) * bf_lo(g.z), bf_hi(ov.z) * bf_hi(g.z)); res.w = pk2(bf_lo(ov.w) * bf_lo(g.w), bf_hi(ov.w) * bf_hi(g.w));
            *(GAS v4u*)(gap + (size_t)(8 * i) * (2 * DM)) = res; }
        LDS_WAIT();
    }
    __syncthreads();
}

struct EpiMix {
    static constexpr bool PERM = true, HAS_MID = true;
    const bf16* MG; bf16* MIX;
    __device__ __forceinline__ void mid(pg8::f32x4 (&acc)[2][2][4][2], const pg8::Unit& u, int wr, int wc, int fr, int fq) const {
        int row0 = u.pm * 256 + wr * 64 + fr, col0 = u.pn * 256 + wc * 32 + 8 * fq;
        asm volatile("" : "+v"(row0), "+v"(col0));
#pragma unroll
        for (int ai = 0; ai < 2; ++ai)
#pragma unroll
            for (int m = 0; m < 4; ++m) { const bf16* gp = MG + (size_t)(row0 + ai * 128 + m * 16) * (2 * DM) + col0;
#pragma unroll
                for (int bj = 0; bj < 2; ++bj) { const v4u ga = *(const GAS v4u*)(gp + 128 * bj), gb = *(const GAS v4u*)(gp + DM + 128 * bj);
                    pg8::f32x4 r0, r1;
                    r0[0] = bf_lo(ga.x) * __builtin_amdgcn_rcpf(bf_lo(gb.x)); r0[1] = bf_hi(ga.x) * __builtin_amdgcn_rcpf(bf_hi(gb.x)); r0[2] = bf_lo(ga.y) * __builtin_amdgcn_rcpf(bf_lo(gb.y)); r0[3] = bf_hi(ga.y) * __builtin_amdgcn_rcpf(bf_hi(gb.y));
                    r1[0] = bf_lo(ga.z) * __builtin_amdgcn_rcpf(bf_lo(gb.z)); r1[1] = bf_hi(ga.z) * __builtin_amdgcn_rcpf(bf_hi(gb.z)); r1[2] = bf_lo(ga.w) * __builtin_amdgcn_rcpf(bf_lo(gb.w)); r1[3] = bf_hi(ga.w) * __builtin_amdgcn_rcpf(bf_hi(gb.w));
                    acc[ai][bj][m][0] *= r0; acc[ai][bj][m][1] *= r1; }
                asm volatile("" : "+v"(acc[ai][0][m][0]), "+v"(acc[ai][0][m][1]), "+v"(acc[ai][1][m][0]), "+v"(acc[ai][1][m][1]));
                asm volatile("" ::: "memory"); }
    }
    __device__ __forceinline__ void operator()(const pg8::f32x4 (&acc)[2][2][4][2], const pg8::Unit& u, int wr, int wc, int fr, int fq) const {
        const int row0 = u.pm * 256 + wr * 64 + fr, col0 = u.pn * 256 + wc * 32 + 8 * fq;
#pragma unroll
        for (int ai = 0; ai < 2; ++ai)
#pragma unroll
            for (int m = 0; m < 4; ++m) { const size_t row = (size_t)(row0 + ai * 128 + m * 16); const bf16* gp = MG + row * (2 * DM) + DM + col0;
#pragma unroll
                for (int bj = 0; bj < 2; ++bj) { const v4u gb = *(const GAS v4u*)(gp + 128 * bj); const pg8::f32x4 v0 = acc[ai][bj][m][0], v1 = acc[ai][bj][m][1];
                    v4u wv; wv.x = pk2(v0[0] * bf_lo(gb.x), v0[1] * bf_hi(gb.x)); wv.y = pk2(v0[2] * bf_lo(gb.y), v0[3] * bf_hi(gb.y)); wv.z = pk2(v1[0] * bf_lo(gb.z), v1[1] * bf_hi(gb.z)); wv.w = pk2(v1[2] * bf_lo(gb.w), v1[3] * bf_hi(gb.w));
                    *(GAS v4u*)(MIX + row * DM + col0 + 128 * bj) = wv; } }
    }
};
struct EpiOut {
    static constexpr bool PERM = false, HAS_MID = false;
    const float *x, *stats, *lne_g, *lne_b, *b_o; float* out; float* lnp;
    __device__ __forceinline__ void operator()(const pg8::f32x4 (&acc)[2][2][4][2], const pg8::Unit& u, int wr, int wc, int fr, int fq) const {
        const int row0 = u.pm * 256 + wr * 64 + fr;
        float ps[2][4], pq[2][4]; f32x2 st[2][4];
#pragma unroll
        for (int ai = 0; ai < 2; ++ai)
#pragma unroll
            for (int m = 0; m < 4; ++m) { ps[ai][m] = 0.f; pq[ai][m] = 0.f; st[ai][m] = *(const GAS f32x2*)(stats + 2 * (row0 + ai * 128 + m * 16)); }
#pragma unroll
        for (int bj = 0; bj < 2; ++bj)
#pragma unroll
            for (int n = 0; n < 2; ++n) { const int col = u.pn * 256 + bj * 128 + wc * 32 + n * 16 + 4 * fq;
                const f32x4 bo = *(const GAS f32x4*)(b_o + col), gg = *(const GAS f32x4*)(lne_g + col), be = *(const GAS f32x4*)(lne_b + col);
#pragma unroll
                for (int ai = 0; ai < 2; ++ai)
#pragma unroll
                    for (int m = 0; m < 4; ++m) { const size_t off = (size_t)(row0 + ai * 128 + m * 16) * DM + col; const f32x4 xv = *(const GAS f32x4*)(x + off);
                        const f32x4 h = (xv - st[ai][m].x) * st[ai][m].y * gg + be; const f32x4 v = acc[ai][bj][m][n] + bo + DN_ALPHA * h;
                        *(GAS f32x4*)(out + off) = v; ps[ai][m] += (v.x + v.y) + (v.z + v.w); pq[ai][m] += (v.x * v.x + v.y * v.y) + (v.z * v.z + v.w * v.w); } }
#pragma unroll
        for (int ai = 0; ai < 2; ++ai)
#pragma unroll
            for (int m = 0; m < 4; ++m) { float s = ps[ai][m], q2 = pq[ai][m]; s += __shfl_xor(s, 16); s += __shfl_xor(s, 32); q2 += __shfl_xor(q2, 16); q2 += __shfl_xor(q2, 32);
                if (fq == 0) *(GAS f32x2*)(lnp + ((size_t)(row0 + ai * 128 + m * 16) * 32 + 4 * u.pn + wc) * 2) = (f32x2){s, q2}; }
    }
};

struct Args { const float* in[20]; float* out; unsigned char* ws; int ph_lo, ph_hi; };
__global__ void __launch_bounds__(NWAVES * 64, 2) hyb_fwd(Args args) {
    extern __shared__ __attribute__((aligned(16))) unsigned char lds[];
    Frame F;
    F.lds = (LAS unsigned char*)lds; F.MISC = (volatile LAS unsigned*)(F.lds + MISC_OFF);
    F.tid = threadIdx.x; F.lane = F.tid & 63; F.wave = __builtin_amdgcn_readfirstlane(F.tid >> 6);
    F.G = gridDim.x; { const int bx = blockIdx.x; F.vcu = (F.G % 8 == 0) ? (bx % 8) * (F.G / 8) + bx / 8 : bx; }
    F.ws = args.ws; F.ctl = (gu32*)(args.ws + WS_CTL); F.out = args.out;
    F.x = args.in[0]; F.meta = args.in[1]; F.lne_g = args.in[2]; F.lne_b = args.in[3]; F.w_in = args.in[4]; F.b_in = args.in[5]; F.conv_w = args.in[6]; F.conv_b = args.in[7];
    F.w_ra = args.in[8]; F.b_ra = args.in[9]; F.w_ri = args.in[10]; F.b_ri = args.in[11]; F.lam = args.in[12]; F.sinks = args.in[13]; F.w_rnn = args.in[14]; F.w_attn = args.in[15];
    F.w_o = args.in[16]; F.b_o = args.in[17]; F.ln_g = args.in[18]; F.ln_b = args.in[19];
    for (int u = F.tid; u < (LDS_BYTES - LDSCTL_OFF) / 4; u += NWAVES * 64) ((LAS unsigned*)(F.lds + LDSCTL_OFF))[u] = 0u;
    __syncthreads();
    XcdBarrier bar; bar.bar = (unsigned*)(F.ctl + CW_BAR); bar.x = 0; bar.st = nullptr;
    if (!MK_SPLIT) bar = xcd_barrier_post((unsigned*)(F.ctl + CW_BAR), F.MISC + 8);
    const int lo = args.ph_lo, hi = args.ph_hi;
#ifndef PH_MASK
#define PH_MASK 63
#endif
#define IN(k) (((PH_MASK >> (k)) & 1) && lo <= (k) && (k) < hi)
#define SEAM(k) do { if (IN(k) && IN((k) + 1)) xcd_barrier(bar); } while (0)

    if (IN(0)) { p0_prologue(F); }
    SEAM(0);
    if (IN(1)) {
        pg8::Gemm g{(const bf16*)((unsigned char*)F.out + OUT_H), (const bf16*)(F.ws + WS_WIN), M, DIN, DM}; pg8::StaticOrder S; S.init(M, DIN, F.G, (int)blockIdx.x);
        EpiZ E{F.b_in, (const float*)(F.ws + WS_ROPE), (const float*)(F.ws + WS_ROPE) + TT * 32, (bf16*)(F.ws + WS_XR), (bf16*)(F.ws + WS_AC), (bf16*)((unsigned char*)F.out + OUT_Q), (bf16*)(F.ws + WS_K), (bf16*)(F.ws + WS_V), (bf16*)(F.ws + WS_MG)};
        pg8::gemm_phase<EpiZ, pg8::StaticOrder, true, true>(F.lds, g, S, E);
    }
    SEAM(1);
    if (IN(2)) {
        p2_scan_item(F, F.vcu);
        p2_attn_item(F, 2 * F.vcu); p2_attn_item(F, 2 * F.vcu + 1);
    }
    SEAM(2);
    if (IN(3)) {
        pg8::Gemm g{(const bf16*)(F.ws + WS_AC), (const bf16*)(F.ws + WS_WY), M, DM, 2 * DM}; pg8::StaticOrder S; S.init(M, DM, F.G, (int)blockIdx.x);
        EpiMix E{(const bf16*)(F.ws + WS_MG), (bf16*)(F.ws + WS_MIX)};
        pg8::gemm_phase<EpiMix, pg8::StaticOrder, true, true>(F.lds, g, S, E);
    }
    SEAM(3);
    if (IN(4)) {
        pg8::Gemm g{(const bf16*)(F.ws + WS_MIX), (const bf16*)(F.ws + WS_WO), M, DM, DM}; pg8::StaticOrder S; S.init(M, DM, F.G, (int)blockIdx.x);
        EpiOut E{F.x, (const float*)(F.ws + WS_STATS), F.lne_g, F.lne_b, F.b_o, F.out, (float*)(F.ws + WS_LNP)};
        pg8::gemm_phase<EpiOut, pg8::StaticOrder, true, true>(F.lds, g, S, E);
    }
    SEAM(4);
    if (IN(5)) {
        const float* lnp = (const float*)(F.ws + WS_LNP);
        const int gw = F.vcu * NWAVES + F.wave, NGW = F.G * NWAVES;
        for (int m = gw; m < M; m += NGW) {
            float s = 0.f, q2 = 0.f; if (F.lane < 32) { const f32x2 p = *(const GAS f32x2*)(lnp + ((size_t)m * 32 + F.lane) * 2); s = p.x; q2 = p.y; }
            s = wave_sum(s); q2 = wave_sum(q2);
            const float mean = s * (1.f / DM), var = fmaxf(q2 * (1.f / DM) - mean * mean, 0.f), rstd = 1.f / sqrtf(var + LN_EPS);
            GAS f32x4* o = (GAS f32x4*)(F.out + (size_t)m * DM) + F.lane;
#pragma unroll
            for (int j = 0; j < 8; ++j) { const f32x4 v = o[64 * j], gg = *((const GAS f32x4*)F.ln_g + F.lane + 64 * j), bb = *((const GAS f32x4*)F.ln_b + F.lane + 64 * j);
                o[64 * j] = (v - mean) * rstd * gg + bb; }
        }
    }
#undef IN
#undef SEAM
}

extern "C" void kernel_launch(void* const* d_in, const int* in_sizes, int n_in, void* d_out, int out_size, void* d_ws, size_t ws_size, hipStream_t stream) {
    static int grid = 0;
    if (grid == 0) {
        if (n_in != 20 || in_sizes[0] != M * DM || out_size != M * DM || ws_size < WS_END) {
            fprintf(stderr, "kernel_launch: unexpected shapes: n_in %d in0 %d out %d ws %zu (need >= %zu)\n", n_in, n_in > 0 ? in_sizes[0] : -1, out_size, ws_size, (size_t)WS_END); grid = -1; return; }
        int dev = 0, cus = 0;
        if (hipGetDevice(&dev) != hipSuccess || hipDeviceGetAttribute(&cus, hipDeviceAttributeMultiprocessorCount, dev) != hipSuccess) { grid = -1; return; }
        if (hipFuncSetAttribute((const void*)hyb_fwd, hipFuncAttributeMaxDynamicSharedMemorySize, LDS_BYTES) != hipSuccess) { fprintf(stderr, "kernel_launch: hipFuncSetAttribute failed\n"); grid = -1; return; }
        (void)hipGetLastError();
        grid = cus;
        if (grid != 256) fprintf(stderr, "kernel_launch: %d CUs; this kernel is laid out for 256\n", grid);
    }
    if (grid < 0) return;
    if (hipMemsetAsync((char*)d_ws + WS_CTL, 0, CTL_ZERO_BYTES, stream) != hipSuccess) return;
    Args a{};
    for (int i = 0; i < 20; ++i) a.in[i] = (const float*)d_in[i];
    a.out = (float*)d_out; a.ws = (unsigned char*)d_ws;
#if MK_SPLIT
#ifndef PROBE_SEQ
#define PROBE_SEQ {0, 1, 2, 3, 4, 5}
#endif
    { const int seq[] = PROBE_SEQ;
      for (int i = 0; i < (int)(sizeof(seq) / sizeof(seq[0])); ++i) { a.ph_lo = seq[i]; a.ph_hi = seq[i] + 1; hipLaunchKernelGGL(hyb_fwd, dim3(grid), dim3(NWAVES * 64), LDS_BYTES, stream, a); } }
#else
    a.ph_lo = 0; a.ph_hi = 6; hipLaunchKernelGGL(hyb_fwd, dim3(grid), dim3(NWAVES * 64), LDS_BYTES, stream, a);
#endif
}
```
